# Optimizing an MI355X kernel written in HIP

```python
import math
import jax, jax.numpy as jnp
from jax import lax
import numpy as np

D_MODEL = 1024
BATCH = 8
SEQ = 4096
DEPTH = 1

HEAD_DIM = 64
A_HEADS = 4
A_VDIM = 2 * HEAD_DIM
B_HEADS = 8
B_KV_HEADS = 2
B_GROUP = B_HEADS // B_KV_HEADS
A_OUT = A_HEADS * A_VDIM
B_OUT = B_HEADS * HEAD_DIM
D_MIX = A_OUT + B_OUT
A_QK = A_HEADS * 2 * HEAD_DIM
B_Q = B_HEADS * HEAD_DIM
B_KV = B_KV_HEADS * HEAD_DIM
SPLITS = (A_QK, A_QK, A_OUT, B_Q, B_KV, B_KV)
D_IN_PROJ = sum(SPLITS)
Q_BLOCK = 128
GRID_W = 64
ROPE_THETA = 10000.0
EPS = 1e-6
N_EXPERTS = 32
TOP_K = 4
D_EXPERT = 1024
SWIGLU_LIMIT = 7.0
SWIGLU_ALPHA = 1.702
MOE_BLOCK = 256

kernel_name = "hymba_diffattn_axialgqa_moe_encoder"


def lambda_init(layer):
    return 0.8 - 0.6 * math.exp(-0.3 * layer)


def rms_norm(x, g):
    xf = x.astype(jnp.float32)
    y = xf * lax.rsqrt(jnp.mean(xf * xf, axis=-1, keepdims=True) + EPS)
    return (y * g.astype(jnp.float32)).astype(x.dtype)


def rope_freqs(dim):
    return ROPE_THETA ** (-(jnp.arange(0, dim, 2, dtype=jnp.float32) / dim))


def apply_rope(x, ang):
    cos = jnp.cos(ang).astype(x.dtype)
    sin = jnp.sin(ang).astype(x.dtype)
    x1, x2 = jnp.split(x, 2, axis=-1)
    return jnp.concatenate([x1 * cos - x2 * sin, x2 * cos + x1 * sin], axis=-1)


def to_blocks(t):
    s, d = t.shape[-2], t.shape[-1]
    t = t.reshape(*t.shape[:-2], s // Q_BLOCK, Q_BLOCK, d)
    return jnp.moveaxis(t, -3, 0)


def from_blocks(o):
    o = jnp.moveaxis(o, 0, -3)
    return o.reshape(*o.shape[:-3], o.shape[-3] * o.shape[-2], o.shape[-1])


def diff_attention(q1, q2, k1, k2, v, lam):
    scale = HEAD_DIM ** -0.5

    def block(qs):
        qb1, qb2 = qs
        s1 = jnp.einsum('bhqd,bhkd->bhqk', qb1, k1).astype(jnp.float32) * scale
        s2 = jnp.einsum('bhqd,bhkd->bhqk', qb2, k2).astype(jnp.float32) * scale
        p = jax.nn.softmax(s1, axis=-1) - lam * jax.nn.softmax(s2, axis=-1)
        return jnp.einsum('bhqk,bhkd->bhqd', p.astype(v.dtype), v)

    return from_blocks(lax.map(block, (to_blocks(q1), to_blocks(q2))))


def gqa_attention(q, k, v):
    scale = HEAD_DIM ** -0.5

    def block(qb):
        s = jnp.einsum('bgrqd,bgkd->bgrqk', qb, k).astype(jnp.float32) * scale
        p = jax.nn.softmax(s, axis=-1)
        return jnp.einsum('bgrqk,bgkd->bgrqd', p.astype(v.dtype), v)

    return from_blocks(lax.map(block, to_blocks(q)))


def moe_ffn(h, router_w, router_b, w_gate, b_gate, w_up, b_up, w_down, b_down):
    b, s, d = h.shape
    n = b * s
    xf = h.reshape(n, d)
    logits = xf.astype(jnp.float32) @ router_w.astype(jnp.float32) + router_b.astype(jnp.float32)
    top_vals, top_idx = lax.top_k(logits, TOP_K)
    gates = jax.nn.softmax(top_vals, axis=-1)
    nk = n * TOP_K
    expert_flat = top_idx.reshape(nk)
    gates_flat = gates.reshape(nk)
    token_of = jnp.arange(nk, dtype=jnp.int32) // TOP_K
    order = jnp.argsort(expert_flat)
    sorted_e = expert_flat[order]
    counts = jnp.zeros((N_EXPERTS,), jnp.int32).at[expert_flat].add(1)
    offsets = jnp.cumsum(counts) - counts
    padded = ((counts + MOE_BLOCK - 1) // MOE_BLOCK) * MOE_BLOCK
    pad_end = jnp.cumsum(padded)
    pad_start = pad_end - padded
    rank = jnp.arange(nk, dtype=jnp.int32) - offsets[sorted_e]
    dest = pad_start[sorted_e] + rank
    n_slots = nk + N_EXPERTS * MOE_BLOCK
    n_blocks = n_slots // MOE_BLOCK
    slot_token = jnp.full((n_slots,), n, jnp.int32).at[dest].set(token_of[order])
    slot_gate = jnp.zeros((n_slots,), jnp.float32).at[dest].set(gates_flat[order])
    block_start = jnp.arange(n_blocks, dtype=jnp.int32) * MOE_BLOCK
    block_expert = jnp.clip(jnp.searchsorted(pad_end, block_start, side='right'), 0, N_EXPERTS - 1)
    xpad = jnp.concatenate([xf, jnp.zeros((1, d), xf.dtype)], axis=0)
    xs = xpad[slot_token].reshape(n_blocks, MOE_BLOCK, d)

    def expert_block(args):
        xb, e = args
        g = xb @ w_gate[e] + b_gate[e]
        u = xb @ w_up[e] + b_up[e]
        g = jnp.minimum(g, SWIGLU_LIMIT)
        u = jnp.clip(u, -SWIGLU_LIMIT, SWIGLU_LIMIT)
        mid = (u + 1.0) * (g * jax.nn.sigmoid(SWIGLU_ALPHA * g))
        return mid @ w_down[e] + b_down[e]

    ys = lax.map(expert_block, (xs, block_expert)).reshape(n_slots, d)
    out = jnp.zeros((n + 1, d), ys.dtype).at[slot_token].add(ys * slot_gate[:, None].astype(ys.dtype))
    return out[:n].reshape(b, s, d)


def setup_inputs(seed: int = 0) -> dict:
    key = jax.random.key(seed)
    ks = jax.random.split(key, 24)
    f = jnp.float32

    def nrm(k, shape, scale):
        return jax.random.normal(k, shape, f) * scale

    def gain(k, shape):
        return 1.0 + 0.02 * jax.random.normal(k, shape, f)

    L = DEPTH
    return {
        "x": jax.random.normal(ks[0], (BATCH, SEQ, D_MODEL), f),
        "norm1_g": gain(ks[1], (L, D_MODEL)),
        "w_in": nrm(ks[2], (L, D_MODEL, D_IN_PROJ), D_MODEL ** -0.5),
        "a_qnorm_g": gain(ks[3], (L, HEAD_DIM)),
        "a_knorm_g": gain(ks[4], (L, HEAD_DIM)),
        "a_lq1": nrm(ks[5], (L, HEAD_DIM), 0.1),
        "a_lk1": nrm(ks[6], (L, HEAD_DIM), 0.1),
        "a_lq2": nrm(ks[7], (L, HEAD_DIM), 0.1),
        "a_lk2": nrm(ks[8], (L, HEAD_DIM), 0.1),
        "a_subln_g": gain(ks[9], (L, A_VDIM)),
        "b_qnorm_g": gain(ks[10], (L, HEAD_DIM)),
        "b_knorm_g": gain(ks[11], (L, HEAD_DIM)),
        "w_out": nrm(ks[12], (L, D_MIX, D_MODEL), D_MIX ** -0.5),
        "norm2_g": gain(ks[13], (L, D_MODEL)),
        "router_w": nrm(ks[14], (L, D_MODEL, N_EXPERTS), D_MODEL ** -0.5),
        "router_b": nrm(ks[15], (L, N_EXPERTS), 0.01),
        "w_gate": nrm(ks[16], (L, N_EXPERTS, D_MODEL, D_EXPERT), D_MODEL ** -0.5),
        "b_gate": nrm(ks[17], (L, N_EXPERTS, D_EXPERT), 0.01),
        "w_up": nrm(ks[18], (L, N_EXPERTS, D_MODEL, D_EXPERT), D_MODEL ** -0.5),
        "b_up": nrm(ks[19], (L, N_EXPERTS, D_EXPERT), 0.01),
        "w_down": nrm(ks[20], (L, N_EXPERTS, D_EXPERT, D_MODEL), D_EXPERT ** -0.5),
        "b_down": nrm(ks[21], (L, N_EXPERTS, D_MODEL), 0.01),
    }


def reference(x, norm1_g, w_in, a_qnorm_g, a_knorm_g, a_lq1, a_lk1, a_lq2, a_lk2,
              a_subln_g, b_qnorm_g, b_knorm_g, w_out, norm2_g, router_w, router_b,
              w_gate, b_gate, w_up, b_up, w_down, b_down):
    b, s, _ = x.shape
    rows = s // GRID_W
    t = jnp.arange(s, dtype=jnp.float32)
    ang_1d = t[:, None] * rope_freqs(HEAD_DIM)[None, :]
    row = jnp.repeat(jnp.arange(rows, dtype=jnp.float32), GRID_W)
    col = jnp.tile(jnp.arange(GRID_W, dtype=jnp.float32), rows)
    f_ax = rope_freqs(HEAD_DIM // 2)
    ang_2d = jnp.concatenate([row[:, None] * f_ax[None, :], col[:, None] * f_ax[None, :]], axis=-1)
    split_idx = list(np.cumsum(SPLITS)[:-1])

    for layer in range(DEPTH):
        lam_init = lambda_init(layer)
        h = rms_norm(x, norm1_g[layer])
        proj = h @ w_in[layer]
        qa, ka, va, qb, kb, vb = jnp.split(proj, split_idx, axis=-1)

        qa = qa.reshape(b, s, A_HEADS, 2, HEAD_DIM).transpose(3, 0, 2, 1, 4)
        ka = ka.reshape(b, s, A_HEADS, 2, HEAD_DIM).transpose(3, 0, 2, 1, 4)
        va = va.reshape(b, s, A_HEADS, A_VDIM).transpose(0, 2, 1, 3)
        qa = apply_rope(rms_norm(qa, a_qnorm_g[layer]), ang_1d)
        ka = apply_rope(rms_norm(ka, a_knorm_g[layer]), ang_1d)
        lam = (jnp.exp(jnp.sum(a_lq1[layer].astype(jnp.float32) * a_lk1[layer].astype(jnp.float32)))
               - jnp.exp(jnp.sum(a_lq2[layer].astype(jnp.float32) * a_lk2[layer].astype(jnp.float32)))
               + lam_init)
        oa = diff_attention(qa[0], qa[1], ka[0], ka[1], va, lam)
        oa = rms_norm(oa, a_subln_g[layer]) * (1.0 - lam_init)
        oa = oa.transpose(0, 2, 1, 3).reshape(b, s, A_OUT)

        qb = qb.reshape(b, s, B_HEADS, HEAD_DIM).transpose(0, 2, 1, 3)
        kb = kb.reshape(b, s, B_KV_HEADS, HEAD_DIM).transpose(0, 2, 1, 3)
        vb = vb.reshape(b, s, B_KV_HEADS, HEAD_DIM).transpose(0, 2, 1, 3)
        qb = apply_rope(rms_norm(qb, b_qnorm_g[layer]), ang_2d)
        kb = apply_rope(rms_norm(kb, b_knorm_g[layer]), ang_2d)
        qb = qb.reshape(b, B_KV_HEADS, B_GROUP, s, HEAD_DIM)
        ob = gqa_attention(qb, kb, vb)
        ob = ob.reshape(b, B_HEADS, s, HEAD_DIM).transpose(0, 2, 1, 3).reshape(b, s, B_OUT)

        x = x + jnp.concatenate([oa, ob], axis=-1) @ w_out[layer]

        h2 = rms_norm(x, norm2_g[layer])
        x = x + moe_ffn(h2, router_w[layer], router_b[layer], w_gate[layer], b_gate[layer],
                        w_up[layer], b_up[layer], w_down[layer], b_down[layer])
    return x
```

```cpp
#include <hip/hip_runtime.h>
#include <hip/hip_bf16.h>
#include <hip/hip_cooperative_groups.h>
#include <cstdio>
#include <cstdint>
#include <cmath>
namespace cg = cooperative_groups;

#define LAS __attribute__((address_space(3)))
#define GAS __attribute__((address_space(1)))
typedef unsigned short bf16_t;
typedef short bf16x8 __attribute__((ext_vector_type(8)));
typedef float f32x4 __attribute__((ext_vector_type(4)));
typedef float f32x2 __attribute__((ext_vector_type(2)));
typedef unsigned u32x4 __attribute__((ext_vector_type(4)));
typedef unsigned u32x2 __attribute__((ext_vector_type(2)));

constexpr int BATCH = 8, SEQ = 4096, DMODEL = 1024, MTOK = BATCH * SEQ;
constexpr int NPROJ = 2304, KDIM = 1024;
constexpr int NEXP = 32, TOPK = 4, DEXP = 1024, NBIN = NEXP * TOPK, CAP = MTOK;
constexpr float EPS = 1e-6f;
constexpr float C2 = 0.125f * 1.4426950408889634f;
constexpr float LAM_INIT = 0.2f;
constexpr int NWAVES = 8, NTHR = 512;

constexpr size_t MiB = 1u << 20;
constexpr size_t WS_CTL = 0;
constexpr int CW_BAR = 1024; constexpr size_t CTL_ZERO_BYTES = 65536;
constexpr int CW_BIN = 8192, BIN_STRIDE = 32;
constexpr size_t WS_TAB = 1 * MiB;
constexpr size_t WS_WR = 3 * MiB;
constexpr size_t WS_RSTD = 3 * MiB + 128 * 1024;
constexpr size_t WS_GN = 3 * MiB + 256 * 1024;
constexpr size_t WS_WIN = 4 * MiB;
constexpr size_t WS_WOUT = 9 * MiB;
constexpr size_t WS_TP = 3 * MiB + 512 * 1024;
constexpr size_t WS_WD = 11 * MiB;
constexpr size_t WS_ENT = 43 * MiB;
constexpr size_t WS_MID = 91 * MiB;
constexpr size_t WS_XN = WS_MID, WS_CAT = WS_MID + 64 * MiB;
constexpr size_t WS_OAP = 459 * MiB;
constexpr size_t WS_SIG = 2 * MiB;
constexpr size_t WS_Y = 219 * MiB;
constexpr size_t WS_X1B = 347 * MiB;
constexpr size_t WS_WGU = WS_Y;
constexpr size_t WS_X18 = WS_Y + 64 * MiB;
constexpr size_t WS_QA = WS_Y + 96 * MiB, WS_KA = WS_QA + 32 * MiB, WS_VA = WS_QA + 64 * MiB, WS_QB = WS_QA + 96 * MiB, WS_KB = WS_QA + 128 * MiB, WS_VB = WS_QA + 136 * MiB;
constexpr size_t WS_END = 523 * MiB;

constexpr int RING_BYTES = 131072, MISC_OFF = RING_BYTES, LDS_BYTES = 147456;
constexpr int MS_CNT = 0, MS_NE = 128, MS_BASE = 160, MS_TILE = 200, MS_CUM = 256, MS_ADJ = 384;
constexpr int MS_TEXP = 512;
constexpr int EPM_OFF = 131072 + 12288;
constexpr int MS_BARST = 2048;

#define RLX_AGENT __ATOMIC_RELAXED, __HIP_MEMORY_SCOPE_AGENT
__device__ __forceinline__ unsigned cvt_pk_bf16(float lo, float hi) { unsigned r; asm volatile("v_cvt_pk_bf16_f32 %0, %1, %2" : "=v"(r) : "v"(lo), "v"(hi)); return r; }
__device__ __forceinline__ float clamp448(float v) { return __builtin_amdgcn_fmed3f(v, -448.0f, 448.0f); }
__device__ __forceinline__ unsigned pk4_fp8(float a, float b, float c, float d) {
    int w = 0; w = __builtin_amdgcn_cvt_pk_fp8_f32(clamp448(a), clamp448(b), w, false); w = __builtin_amdgcn_cvt_pk_fp8_f32(clamp448(c), clamp448(d), w, true); return (unsigned)w; }
__device__ __forceinline__ float bf_lo(unsigned w) { return __uint_as_float(w << 16); }
__device__ __forceinline__ float bf_hi(unsigned w) { return __uint_as_float(w & 0xffff0000u); }
template <int CTRL> __device__ __forceinline__ float dppf(float v) { return __int_as_float(__builtin_amdgcn_update_dpp(0, __float_as_int(v), CTRL, 0xf, 0xf, false)); }
template <int CTRL> __device__ __forceinline__ int dppi(int v) { return __builtin_amdgcn_update_dpp(0, v, CTRL, 0xf, 0xf, false); }
__device__ __forceinline__ float xor1f(float v) { return dppf<0xB1>(v); }
__device__ __forceinline__ float xor2f(float v) { return dppf<0x4E>(v); }
__device__ __forceinline__ float xor4f(float v) { return dppf<0x1B>(dppf<0x141>(v)); }
__device__ __forceinline__ float xor8f(float v) { return dppf<0x128>(v); }
__device__ __forceinline__ int xor2i(int v) { return dppi<0x4E>(v); }
__device__ __forceinline__ int xor4i(int v) { return dppi<0x1B>(dppi<0x141>(v)); }
__device__ __forceinline__ int xor8i(int v) { return dppi<0x128>(v); }
__device__ __forceinline__ float xor16f(float v, int lane) { const auto r = __builtin_amdgcn_permlane16_swap(__float_as_uint(v), __float_as_uint(v), false, false); return __uint_as_float((lane & 16) ? r[0] : r[1]); }
__device__ __forceinline__ float xor32f(float v, int lane) { const auto r = __builtin_amdgcn_permlane32_swap(__float_as_uint(v), __float_as_uint(v), false, false); return __uint_as_float((lane & 32) ? r[0] : r[1]); }
__device__ __forceinline__ int xor16i(int v, int lane) { const auto r = __builtin_amdgcn_permlane16_swap((unsigned)v, (unsigned)v, false, false); return (int)((lane & 16) ? r[0] : r[1]); }
__device__ __forceinline__ int xor32i(int v, int lane) { const auto r = __builtin_amdgcn_permlane32_swap((unsigned)v, (unsigned)v, false, false); return (int)((lane & 32) ? r[0] : r[1]); }
__device__ __forceinline__ float sum16f(float v) { const auto r = __builtin_amdgcn_permlane16_swap(__float_as_uint(v), __float_as_uint(v), false, false); return __uint_as_float(r[0]) + __uint_as_float(r[1]); }
__device__ __forceinline__ float sum32f(float v) { const auto r = __builtin_amdgcn_permlane32_swap(__float_as_uint(v), __float_as_uint(v), false, false); return __uint_as_float(r[0]) + __uint_as_float(r[1]); }
__device__ __forceinline__ float wave_sum(float v) {
#pragma unroll
    for (int o = 1; o < 64; o <<= 1) v += __shfl_xor(v, o);
    return v;
}


#define XB_TMO      128
#define XB_XCNT(j)  (256  + 64 * (j))
#define XB_XSUB(j)  (1280 + 64 * (j))
#define XB_XGEN(j)  (2304 + 64 * (j))
#define XB_TOP      3328
#define XB_TOPGEN   3392
#define XCD_BAR_WORDS 3456
#define XB_SPIN_CAP (1u << 22)
__device__ __forceinline__ unsigned xb_ld(unsigned* p)              { return __hip_atomic_load(p, __ATOMIC_RELAXED, __HIP_MEMORY_SCOPE_AGENT); }
__device__ __forceinline__ unsigned xb_add(unsigned* p, unsigned v) { return __hip_atomic_fetch_add(p, v, __ATOMIC_RELAXED, __HIP_MEMORY_SCOPE_AGENT); }
__device__ __forceinline__ unsigned xb_xcc_id() { return (unsigned)__builtin_amdgcn_s_getreg((3 << 11) | 20) & 0xFu; }
#define XB_SPIN(cond, bar) do { unsigned _sp = 0; while (cond) { __builtin_amdgcn_s_sleep(1); \
    if ((++_sp & 255u) == 0u) { if (xb_ld(&(bar)[XB_TMO])) break; if (_sp > XB_SPIN_CAP) { atomicAdd(&(bar)[XB_TMO], 1u); break; } } } } while (0)
struct XcdBarrier { unsigned* bar; unsigned x; volatile LAS unsigned* st; };
__device__ __forceinline__ XcdBarrier xcd_barrier_post(unsigned* bar, volatile LAS unsigned* st) {
    XcdBarrier b; b.bar = bar; b.x = xb_xcc_id(); b.st = st;
    if (threadIdx.x == 0) (void)xb_add(&bar[XB_XCNT(b.x)], 1u);
    return b;
}
__device__ __forceinline__ void xcd_barrier_complete(unsigned* bar, unsigned x, unsigned& nloc, unsigned& nx) {
    const unsigned G = gridDim.x * gridDim.y * gridDim.z;
    unsigned sum, cnt, mine, sp = 0u;
    for (;;) {
        sum = 0u; cnt = 0u; mine = 0u;
#pragma unroll
        for (unsigned j = 0; j < 16; ++j) { const unsigned c = xb_ld(&bar[XB_XCNT(j)]); sum += c; cnt += (c > 0u) ? 1u : 0u; mine = (j == x) ? c : mine; }
        if (sum == G) break;
        __builtin_amdgcn_s_sleep(1);
        if ((++sp & 255u) == 0u) { if (xb_ld(&bar[XB_TMO])) break; if (sp > XB_SPIN_CAP) { atomicAdd(&bar[XB_TMO], 1u); break; } }
    }
    nloc = mine > 0u ? mine : 1u; nx = cnt > 0u ? cnt : 1u;
}
__device__ __forceinline__ void xcd_barrier(const XcdBarrier& b) {
    asm volatile("s_waitcnt vmcnt(0)" ::: "memory");
    __syncthreads();
    if (threadIdx.x == 0) {
        unsigned* bar = b.bar;
        __builtin_amdgcn_s_waitcnt(0);
        unsigned nloc = b.st[0], nx = b.st[1];
        if (nloc == 0u) { xcd_barrier_complete(bar, b.x, nloc, nx); b.st[0] = nloc; b.st[1] = nx; }
        const unsigned old = xb_add(&bar[XB_XSUB(b.x)], 1u);
        const unsigned gen = old / nloc;
        if (old + 1u == (gen + 1u) * nloc) {
            __builtin_amdgcn_fence(__ATOMIC_RELEASE, "agent");
            asm volatile("s_waitcnt vmcnt(0)" ::: "memory");
            const unsigned og = xb_add(&bar[XB_TOP], 1u);
            const unsigned tg = og / nx;
            if (og + 1u == (tg + 1u) * nx) xb_add(&bar[XB_TOPGEN], 1u);
            else XB_SPIN(xb_ld(&bar[XB_TOPGEN]) == tg, bar);
            __builtin_amdgcn_fence(__ATOMIC_ACQUIRE, "agent");
            xb_add(&bar[XB_XGEN(b.x)], 1u);
            asm volatile("s_waitcnt vmcnt(0)" ::: "memory");
        } else {
            XB_SPIN(xb_ld(&bar[XB_XGEN(b.x)]) == gen, bar);
            __builtin_amdgcn_fence(__ATOMIC_ACQUIRE, "agent");
            asm volatile("s_waitcnt vmcnt(0)" ::: "memory");
        }
    }
    __syncthreads();
}

namespace pg8 {
constexpr int BM = 256, BK = 64, HALF = 128, HTB = HALF * BK * 2, STAGE_BYTES = 8 * HTB, NXCD = 8, WGM = 8, K = KDIM;
template <bool FP8> __host__ __device__ __forceinline__ int lds_byte(int r, int col) {
    const int c = col >> 3, low = FP8 ? ((c >> 1) & 1) : (c & 1), mid = FP8 ? (c & 1) : ((c >> 1) & 1);
    return (r >> 3) * 1024 + 16 * (16 * (2 * (c >> 2) + mid) + 2 * (r & 7) + low);
}
template <bool FP8> __host__ __device__ __forceinline__ void stage_rc(int b, int& R, int& C) {
    const int blk = b >> 10, p = (b & 1023) >> 4, r7 = (p & 15) >> 1, low = p & 1, A = p >> 5, B = (p >> 4) & 1;
    const int c = FP8 ? (4 * A + 2 * low + B) : (4 * A + 2 * B + low);
    R = 8 * blk + r7; C = 8 * c;
}
__host__ __device__ __forceinline__ int perm32(int rho) { const int n = rho >> 4, i = rho & 15; return 8 * (i >> 2) + 4 * n + (i & 3); }

struct Unit { int pm, pn, e, r0, nrows; };


typedef int v8i __attribute__((ext_vector_type(8)));
typedef int v4i __attribute__((ext_vector_type(4)));
template <bool FP8, class Epi, class Sched>
__device__ __forceinline__ void gemm_phase(LAS unsigned char* lds, const char* gA, const Sched& S, const Epi& E) {
    int tid_ = threadIdx.x; asm volatile("" : "+v"(tid_));
    const int tid = tid_, wid = __builtin_amdgcn_readfirstlane(tid >> 6), lane = tid & 63, wr = wid >> 2, wc = wid & 3, fr = lane & 15, fq = lane >> 4;
    constexpr int RP = FP8 ? K : 2 * K;
    constexpr int nt = RP / 128;
    int Rs[2], Cs[2]; unsigned voffB[2];
#pragma unroll
    for (int i = 0; i < 2; ++i) { int R, C; stage_rc<FP8>(tid * 16 + i * 8192, R, C);
        const int Rb = Epi::PERM16 ? (64 * (R >> 5) + 16 * ((R & 15) >> 2) + 4 * ((R >> 4) & 1) + (R & 3)) : ((R & ~31) + perm32(R & 31));
        Rs[i] = R; Cs[i] = C; voffB[i] = (unsigned)(Rb * RP + C * 2); }
    const size_t kstep = (size_t)(BK * 2);
    const size_t hstep = (size_t)(Epi::PERM16 ? 8 : HALF) * RP;
    const unsigned ldsw = (unsigned)wid * 1024u;
    const int aoff = lds_byte<FP8>(wr * 64 + fr, FP8 ? fq * 16 : fq * 8), boff = lds_byte<FP8>(wc * 32 + fr, FP8 ? fq * 16 : fq * 8);
    const int scl = 0x7f7f7f7f;
#define PG8_SA(b, h) (((b) * 2 + (h)) * HTB)
#define PG8_SB(b, h) ((4 + (b) * 2 + (h)) * HTB)
#define PG8_STAGE(bufoff, gbase, voff) do { _Pragma("unroll") for (int _i = 0; _i < 2; ++_i) \
        __builtin_amdgcn_global_load_lds((const unsigned*)((const char*)(gbase) + (voff)[_i]), (LAS unsigned*)(lds + (bufoff) + ldsw + _i * 8192), 16, 0, 0); } while (0)
#define PG8_LDA(dst, b, h) do { _Pragma("unroll") for (int m = 0; m < 4; ++m) { \
        if constexpr (FP8) { dst##8[m].lo = *(const LAS v4i*)(lds + PG8_SA(b, h) + aoff + m * 2048); dst##8[m].hi = *(const LAS v4i*)(lds + PG8_SA(b, h) + aoff + m * 2048 + 256); } \
        else { _Pragma("unroll") for (int k = 0; k < 2; ++k) dst[m][k] = *(const LAS bf16x8*)(lds + PG8_SA(b, h) + aoff + m * 2048 + k * 512); } } } while (0)
#define PG8_LDB(dst, b, h) do { _Pragma("unroll") for (int n = 0; n < 2; ++n) { \
        if constexpr (FP8) { dst##8[n].lo = *(const LAS v4i*)(lds + PG8_SB(b, h) + boff + n * 2048); dst##8[n].hi = *(const LAS v4i*)(lds + PG8_SB(b, h) + boff + n * 2048 + 256); } \
        else { _Pragma("unroll") for (int k = 0; k < 2; ++k) dst[n][k] = *(const LAS bf16x8*)(lds + PG8_SB(b, h) + boff + n * 2048 + k * 512); } } } while (0)
#define PG8_ACC(ai, bj, m, n) ((n) == 0 ? acc8[ai][bj][m].lo : acc8[ai][bj][m].hi)
#define PG8_MMA(ai, bj, At, Bt) do { __builtin_amdgcn_s_setprio(1); _Pragma("unroll") for (int m = 0; m < 4; ++m) { \
        if constexpr (FP8) { f32x4 lo_ = acc8[ai][bj][m].lo, hi_ = acc8[ai][bj][m].hi; \
                             if (m == 0) asm volatile("s_nop 1\n\tv_mfma_scale_f32_16x16x128_f8f6f4 %0, %1, %2, %0, %3, %3 op_sel_hi:[0,0,0]" : "+v"(lo_) : "v"(Bt##8[0]), "v"(At##8[m]), "v"(scl)); \
                             else        asm volatile("v_mfma_scale_f32_16x16x128_f8f6f4 %0, %1, %2, %0, %3, %3 op_sel_hi:[0,0,0]" : "+v"(lo_) : "v"(Bt##8[0]), "v"(At##8[m]), "v"(scl)); \
                             asm volatile("v_mfma_scale_f32_16x16x128_f8f6f4 %0, %1, %2, %0, %3, %3 op_sel_hi:[0,0,0]" : "+v"(hi_) : "v"(Bt##8[1]), "v"(At##8[m]), "v"(scl)); \
                             acc8[ai][bj][m].lo = lo_; acc8[ai][bj][m].hi = hi_; } \
        else { _Pragma("unroll") for (int k = 0; k < 2; ++k) { acc8[ai][bj][m].lo = __builtin_amdgcn_mfma_f32_16x16x32_bf16(Bt[0][k], At[m][k], acc8[ai][bj][m].lo, 0, 0, 0); \
                                                                acc8[ai][bj][m].hi = __builtin_amdgcn_mfma_f32_16x16x32_bf16(Bt[1][k], At[m][k], acc8[ai][bj][m].hi, 0, 0, 0); } } } \
        __builtin_amdgcn_s_setprio(0); } while (0)
#define PG8_ZERO(ai) do { _Pragma("unroll") for (int b_ = 0; b_ < 2; ++b_) { _Pragma("unroll") for (int m_ = 0; m_ < 4; ++m_) acc8[ai][b_][m_] = (f32x8){0.f, 0.f, 0.f, 0.f, 0.f, 0.f, 0.f, 0.f}; } } while (0)
#define PG8_WAIT_V(n) asm volatile("s_waitcnt vmcnt(" #n ")" ::: "memory")
#define PG8_WAIT_L(n) asm volatile("s_waitcnt lgkmcnt(" #n ")" ::: "memory")
#define PG8_BAR __builtin_amdgcn_s_barrier()
#define PG8_SCHED __builtin_amdgcn_sched_barrier(0)
    Unit cur, nxt; int ui = 0;
    if (!S.next(0, cur)) return;
    typedef float f32x8 __attribute__((ext_vector_type(8)));
    f32x8 acc8[2][2][4];
#pragma unroll
    for (int a = 0; a < 2; ++a)
#pragma unroll
        for (int b = 0; b < 2; ++b)
#pragma unroll
            for (int m = 0; m < 4; ++m) acc8[a][b][m] = (f32x8){0.f, 0.f, 0.f, 0.f, 0.f, 0.f, 0.f, 0.f};
    bf16x8 At[4][2], B0[2][2], B1[2][2]; v8i At8[4], B08[2], B18[2];
    unsigned aoc[2][2], aon[2][2];
#pragma unroll
    for (int h = 0; h < 2; ++h)
#pragma unroll
        for (int i = 0; i < 2; ++i) aoc[h][i] = S.arow(cur, h * HALF + Rs[i]) + (unsigned)Cs[i] * 2u;
    const char* cB = S.bbase(cur);
    PG8_STAGE(PG8_SB(0, 0), cB, voffB); PG8_STAGE(PG8_SB(0, 1), cB + hstep, voffB); PG8_STAGE(PG8_SA(0, 0), gA, aoc[0]); PG8_STAGE(PG8_SA(0, 1), gA, aoc[1]);
    if (wr == 1) PG8_BAR;
    PG8_WAIT_V(2); PG8_BAR;
    PG8_STAGE(PG8_SB(1, 0), cB + kstep, voffB); PG8_STAGE(PG8_SA(1, 0), gA + kstep, aoc[0]); PG8_STAGE(PG8_SB(1, 1), cB + hstep + kstep, voffB);
    PG8_WAIT_V(6); PG8_BAR;
    for (;;) {
        const bool has_next = S.next(ui + 1, nxt);
        const char* nB = has_next ? S.bbase(nxt) : cB;
#pragma unroll
        for (int h = 0; h < 2; ++h)
#pragma unroll
            for (int i = 0; i < 2; ++i) aon[h][i] = has_next ? (S.arow(nxt, h * HALF + Rs[i]) + (unsigned)Cs[i] * 2u) : aoc[h][i];
#pragma unroll 1
        for (int t = 0; t < nt; t += 2) {
            const bool last = (t == nt - 2);
            if constexpr (Epi::PREDMA) { if (t == nt - 4) E.pre_dma(cur, tid, wid, lds + EPM_OFF); }
            const char* a1 = gA + (size_t)(t + 1) * kstep;
            const char* a2 = last ? gA : gA + (size_t)(t + 2) * kstep; const char* b2 = last ? nB : cB + (size_t)(t + 2) * kstep;
            const char* a3 = a2 + kstep; const char* b3 = b2 + kstep;
            unsigned o2[2][2];
            if (last) {
                asm volatile("" : "+v"(aon[0][0]), "+v"(aon[0][1]), "+v"(aon[1][0]), "+v"(aon[1][1]));
#pragma unroll
                for (int h = 0; h < 2; ++h)
#pragma unroll
                    for (int i = 0; i < 2; ++i) o2[h][i] = aon[h][i];
            } else {
#pragma unroll
                for (int h = 0; h < 2; ++h)
#pragma unroll
                    for (int i = 0; i < 2; ++i) o2[h][i] = aoc[h][i];
            }
            const bool zero_now = (t == 0) && (ui > 0);
            PG8_LDB(B0, 0, 0); PG8_LDB(B1, 0, 1); PG8_SCHED; PG8_LDA(At, 0, 0); PG8_STAGE(PG8_SA(1, 1), a1, aoc[1]);
            if (zero_now) { PG8_ZERO(0); }
            PG8_WAIT_V(8); PG8_WAIT_L(0); PG8_BAR; PG8_MMA(0, 0, At, B0); PG8_MMA(0, 1, At, B1); PG8_BAR; PG8_SCHED;
            PG8_LDA(At, 0, 1); PG8_STAGE(PG8_SB(0, 0), b2, voffB); PG8_STAGE(PG8_SB(0, 1), b2 + hstep, voffB); PG8_STAGE(PG8_SA(0, 0), a2, o2[0]);
            if (zero_now) { PG8_ZERO(1); }
            PG8_WAIT_V(8); PG8_WAIT_L(0); PG8_BAR; PG8_MMA(1, 0, At, B0); PG8_MMA(1, 1, At, B1); PG8_BAR; PG8_SCHED;
            PG8_LDB(B0, 1, 0); PG8_LDB(B1, 1, 1); PG8_SCHED; PG8_LDA(At, 1, 0); PG8_STAGE(PG8_SA(0, 1), a2, o2[1]);
            PG8_WAIT_V(8); PG8_WAIT_L(0); PG8_BAR; PG8_MMA(0, 0, At, B0); PG8_MMA(0, 1, At, B1); PG8_BAR; PG8_SCHED;
            PG8_LDA(At, 1, 1); PG8_STAGE(PG8_SB(1, 0), b3, voffB); PG8_STAGE(PG8_SB(1, 1), b3 + hstep, voffB); PG8_STAGE(PG8_SA(1, 0), a3, o2[0]);
            PG8_WAIT_V(8); PG8_WAIT_L(0); PG8_BAR; PG8_MMA(1, 0, At, B0); PG8_MMA(1, 1, At, B1); PG8_BAR; PG8_SCHED;
        }
        if constexpr (FP8) asm volatile("s_nop 15\n\ts_nop 7" ::: "memory");
        if (wr == 0) PG8_BAR;
        { int fr_ = fr, fq_ = fq; asm volatile("" : "+v"(fr_), "+v"(fq_));
          f32x4 acc[2][2][4][2];
#pragma unroll
          for (int a = 0; a < 2; ++a)
#pragma unroll
              for (int b = 0; b < 2; ++b)
#pragma unroll
                  for (int m = 0; m < 4; ++m) { acc[a][b][m][0] = acc8[a][b][m].lo; acc[a][b][m][1] = acc8[a][b][m].hi; }
          E(acc, cur, wr, wc, fr_, fq_); }
        if (!has_next) break;
        cur = nxt; cB = nB; ++ui;
#pragma unroll
        for (int h = 0; h < 2; ++h)
#pragma unroll
            for (int i = 0; i < 2; ++i) aoc[h][i] = aon[h][i];
        if (wr == 1) PG8_BAR;
    }
    PG8_WAIT_V(0);
    PG8_BAR;
#undef PG8_SA
#undef PG8_SB
#undef PG8_STAGE
#undef PG8_LDA
#undef PG8_LDB
#undef PG8_MMA
#undef PG8_ZERO
#undef PG8_WAIT_V
#undef PG8_WAIT_L
#undef PG8_BAR
#undef PG8_SCHED
}

struct DenseOrder {
    const char* Bt; int nM, nN, nwg, G, c;
    __device__ void init(const void* Bt_, int M, int N, int G_, int c_) { Bt = (const char*)Bt_; nM = M / BM; nN = N / BM; nwg = nM * nN; G = G_; c = c_; }
    __device__ __forceinline__ bool next(int i, Unit& u) const {
        const long L = (long)i * G + c; if (L >= nwg) return false;
        int wgid = (int)L; { const int q = nwg / NXCD, r = nwg % NXCD, xcd = wgid % NXCD, off = wgid / NXCD; wgid = (xcd < r ? xcd * (q + 1) : r * (q + 1) + (xcd - r) * q) + off; }
        const int nig = WGM * nN, gid = wgid / nig, fm = gid * WGM, gsz = (nM - fm) < WGM ? (nM - fm) : WGM;
        u.pm = fm + ((wgid % nig) % gsz); u.pn = (wgid % nig) / gsz; u.e = 0; u.r0 = 0; u.nrows = BM; return true;
    }
    __device__ __forceinline__ const char* bbase(const Unit& u) const { return Bt + (size_t)u.pn * BM * K * 2; }
    __device__ __forceinline__ unsigned arow(const Unit& u, int r) const { return (unsigned)(u.pm * BM + r) * (unsigned)(K * 2); }
};
}

struct Frame {
    LAS unsigned char* lds; LAS int* MS;
    int tid, lane, wave, vcu, G;
    unsigned char* ws; float* out;
    const float* in[22];
};
enum { I_X = 0, I_N1G, I_WIN, I_AQG, I_AKG, I_LQ1, I_LK1, I_LQ2, I_LK2, I_SUBG, I_BQG, I_BKG, I_WOUT, I_N2G, I_RW, I_RB, I_WG, I_BG, I_WU, I_BU, I_WDN, I_BD };

__device__ __forceinline__ size_t moe_idx(const LAS int* MS, int e, int m) {
    const LAS int* cum = MS + MS_CUM + 4 * e; const LAS int* adj = MS + MS_ADJ + 4 * e;
    const int c1 = cum[1], c2 = cum[2], c3 = cum[3];
    int a = adj[0]; a = (m >= c1) ? adj[1] : a; a = (m >= c2) ? adj[2] : a; a = (m >= c3) ? adj[3] : a;
    return (size_t)(unsigned)(m + a);
}
__device__ __forceinline__ int moe_tok(const LAS int* MS, const unsigned char* ws, int e, int m) { return ((const int*)(ws + WS_ENT))[moe_idx(MS, e, m)]; }
struct MoeUpOrder {
    const LAS int* MS; const unsigned char* ws; const char* Bt; int G, vcu;
    __device__ __forceinline__ bool next(int i, pg8::Unit& u) const {
        const LAS int* tp = MS + MS_TILE; const int total = tp[NEXP] * 8;
        const long L = (long)i * G + vcu; if (L >= total) return false;
        const int rt = (int)(L >> 3); u.pn = (int)(L & 7);
        const int e = MS[MS_TEXP + rt];
        u.e = e; u.pm = rt - tp[e]; u.r0 = u.pm * 256; const int ne = MS[MS_NE + e]; u.nrows = (ne - u.r0) < 256 ? (ne - u.r0) : 256; return true;
    }
    __device__ __forceinline__ const char* bbase(const pg8::Unit& u) const { return Bt + ((size_t)u.e * 2048 + (size_t)u.pn * 256) * KDIM; }
    __device__ __forceinline__ unsigned arow(const pg8::Unit& u, int r) const { const int rr = r < u.nrows ? r : u.nrows - 1; return (unsigned)moe_tok(MS, ws, u.e, u.r0 + rr) * (unsigned)KDIM; }
};
struct MoeDownOrder {
    const LAS int* MS; const char* Bt; int G, vcu;
    __device__ __forceinline__ bool next(int i, pg8::Unit& u) const {
        const LAS int* tp = MS + MS_TILE; const int total = tp[NEXP] * 4;
        const long L = (long)i * G + vcu; if (L >= total) return false;
        const int rt = (int)(L >> 2); u.pn = (int)(L & 3);
        const int e = MS[MS_TEXP + rt];
        u.e = e; u.pm = rt - tp[e]; u.r0 = u.pm * 256; const int ne = MS[MS_NE + e]; u.nrows = (ne - u.r0) < 256 ? (ne - u.r0) : 256; return true;
    }
    __device__ __forceinline__ const char* bbase(const pg8::Unit& u) const { return Bt + ((size_t)u.e * 1024 + (size_t)u.pn * 256) * KDIM; }
    __device__ __forceinline__ unsigned arow(const pg8::Unit& u, int r) const {
        const int rr = r < u.nrows ? r : u.nrows - 1;
        return (unsigned)(MS[MS_BASE + u.e] + u.r0 + rr) * (unsigned)KDIM;
    }
};

using pg8::Unit;
struct EpiInProj {
    static constexpr bool PERM16 = false; static constexpr bool PREDMA = false;
    unsigned char* ws; const LAS float* tabs;
    __device__ __forceinline__ void operator()(const f32x4 (&acc)[2][2][4][2], const Unit& u, int wr, int wc, int fr, int fq) const {
        int type, head; const int pn = u.pn;
        if (pn < 2) { type = 0; head = pn * 4 + wc; } else if (pn < 4) { type = 1; head = (pn - 2) * 4 + wc; } else if (pn < 6) { type = 2; head = (pn - 4) * 4 + wc; }
        else if (pn < 8) { type = 3; head = (pn - 6) * 4 + wc; } else if (wc < 2) { type = 4; head = wc; } else { type = 5; head = wc - 2; }
        bf16_t* dst = (bf16_t*)(ws + WS_QA + (size_t)(type <= 3 ? 32 * type : 128 + 8 * (type - 4)) * MiB);
        const int nheads = type <= 3 ? 8 : 2;
        const bool norm = (type != 2 && type != 5);
        const bool axial = type >= 3;
        const LAS float* gn = tabs + 64 * (type == 0 ? 0 : type == 1 ? 1 : type == 3 ? 2 : 3);
        const float scale = (type == 0 || type == 3) ? C2 : 1.0f;
        const int row0 = u.pm * 256 + wr * 64 + fr; const int b = row0 >> 12;
        dst += ((size_t)(b * nheads + head) * SEQ) * 64 + 8 * fq;
        f32x4 g0[2], g1[2], fr2[2];
        if (norm) {
            const LAS float* fqt = tabs + 256 + (axial ? 32 : 0);
#pragma unroll
            for (int n = 0; n < 2; ++n) { g0[n] = *(const LAS f32x4*)(gn + 8 * fq + 4 * n); g1[n] = *(const LAS f32x4*)(gn + 32 + 8 * fq + 4 * n); fr2[n] = *(const LAS f32x4*)(fqt + 8 * fq + 4 * n); }
        }
#pragma unroll
        for (int ai = 0; ai < 2; ++ai)
#pragma unroll
            for (int m = 0; m < 4; ++m) {
                const int s = (row0 + ai * 128 + m * 16) & (SEQ - 1);
                f32x4 v0[2], v1[2];
#pragma unroll
                for (int n = 0; n < 2; ++n) { v0[n] = acc[ai][0][m][n]; v1[n] = acc[ai][1][m][n]; }
                if (norm) {
                    float ss = 0.f;
#pragma unroll
                    for (int n = 0; n < 2; ++n)
#pragma unroll
                        for (int j = 0; j < 4; ++j) ss += v0[n][j] * v0[n][j] + v1[n][j] * v1[n][j];
                    ss += __shfl_xor(ss, 16); ss += __shfl_xor(ss, 32);
                    const float rstd = __builtin_amdgcn_rsqf(ss * (1.0f / 64.0f) + EPS);
                    const float pos = axial ? (float)((fq < 2) ? (s >> 6) : (s & 63)) : (float)s;
#pragma unroll
                    for (int n = 0; n < 2; ++n) {
                        f32x4 c, sn;
#pragma unroll
                        for (int j = 0; j < 4; ++j) { const float rev = __builtin_amdgcn_fractf(pos * fr2[n][j]); c[j] = __builtin_amdgcn_cosf(rev); sn[j] = __builtin_amdgcn_sinf(rev); }
                        const f32x4 y0 = v0[n] * rstd * g0[n], y1 = v1[n] * rstd * g1[n];
                        v0[n] = (y0 * c - y1 * sn) * scale; v1[n] = (y1 * c + y0 * sn) * scale;
                    }
                }
                u32x4 w0, w1;
                w0.x = cvt_pk_bf16(v0[0][0], v0[0][1]); w0.y = cvt_pk_bf16(v0[0][2], v0[0][3]); w0.z = cvt_pk_bf16(v0[1][0], v0[1][1]); w0.w = cvt_pk_bf16(v0[1][2], v0[1][3]);
                w1.x = cvt_pk_bf16(v1[0][0], v1[0][1]); w1.y = cvt_pk_bf16(v1[0][2], v1[0][3]); w1.z = cvt_pk_bf16(v1[1][0], v1[1][1]); w1.w = cvt_pk_bf16(v1[1][2], v1[1][3]);
                bf16_t* p = dst + (size_t)s * 64;
                *(u32x4*)p = w0; *(u32x4*)(p + 32) = w1;
            }
    }
};
struct EpiOutProj {
    static constexpr bool PERM16 = true; static constexpr bool PREDMA = false;
    const bf16_t* xn; const float* sig; bf16_t* x1b; unsigned char* x18;
    __device__ __forceinline__ void operator()(const f32x4 (&acc)[2][2][4][2], const Unit& u, int wr, int wc, int fr, int fq) const {
        const int row0 = u.pm * 256 + wr * 64 + fr, col0 = u.pn * 256 + wc * 64 + 16 * fq;
#pragma unroll
        for (int ai = 0; ai < 2; ++ai) {
            u32x4 xa[4][2]; float sg[4];
#pragma unroll
            for (int m = 0; m < 4; ++m) { const size_t off = (size_t)(row0 + ai * 128 + m * 16) * DMODEL + col0;
                xa[m][0] = __builtin_nontemporal_load((const u32x4*)(xn + off)); xa[m][1] = __builtin_nontemporal_load((const u32x4*)(xn + off + 8)); sg[m] = sig[row0 + ai * 128 + m * 16]; }
#pragma unroll
            for (int m = 0; m < 4; ++m) {
                const size_t off = (size_t)(row0 + ai * 128 + m * 16) * DMODEL + col0;
                f32x4 v[4];
#pragma unroll
                for (int bj = 0; bj < 2; ++bj)
#pragma unroll
                    for (int n = 0; n < 2; ++n) { const unsigned w0 = xa[m][bj][2 * n], w1 = xa[m][bj][2 * n + 1]; f32x4 xv; xv[0] = bf_lo(w0); xv[1] = bf_hi(w0); xv[2] = bf_lo(w1); xv[3] = bf_hi(w1);
                        v[2 * bj + n] = xv * sg[m] + acc[ai][bj][m][n]; }
                u32x4 wb0, wb1, w8;
                wb0.x = cvt_pk_bf16(v[0][0], v[0][1]); wb0.y = cvt_pk_bf16(v[0][2], v[0][3]); wb0.z = cvt_pk_bf16(v[1][0], v[1][1]); wb0.w = cvt_pk_bf16(v[1][2], v[1][3]);
                wb1.x = cvt_pk_bf16(v[2][0], v[2][1]); wb1.y = cvt_pk_bf16(v[2][2], v[2][3]); wb1.z = cvt_pk_bf16(v[3][0], v[3][1]); wb1.w = cvt_pk_bf16(v[3][2], v[3][3]);
                w8.x = pk4_fp8(v[0][0], v[0][1], v[0][2], v[0][3]); w8.y = pk4_fp8(v[1][0], v[1][1], v[1][2], v[1][3]); w8.z = pk4_fp8(v[2][0], v[2][1], v[2][2], v[2][3]); w8.w = pk4_fp8(v[3][0], v[3][1], v[3][2], v[3][3]);
                *(u32x4*)(x1b + off) = wb0; *(u32x4*)(x1b + off + 8) = wb1;
                *(u32x4*)(x18 + off) = w8;
            }
            asm volatile("" ::: "memory");
        }
    }
};
constexpr float SWC = 2.4554669595930156f;
struct EpiSwiglu {
    static constexpr bool PERM16 = false; static constexpr bool PREDMA = true;
    const LAS int* MS; const unsigned char* ws; const float *bg, *bu; unsigned char* mid;
    __device__ __forceinline__ void pre_dma(const Unit& u, int tid, int wid, LAS unsigned char* epm) const {
        const float* src;
        if (wid < 4) { const float* ent_rstd = (const float*)(ws + WS_ENT + (size_t)2 * NBIN * CAP * 4); const int rr = tid < u.nrows ? tid : u.nrows - 1; src = ent_rstd + moe_idx(MS, u.e, u.r0 + rr); }
        else { const int c = tid & 127; src = (wid < 6 ? bg : bu) + u.e * DEXP + u.pn * 128 + c; }
        __builtin_amdgcn_global_load_lds((const unsigned*)src, (LAS unsigned*)(epm + wid * 256), 4, 0, 0);
    }
    __device__ __forceinline__ void operator()(const f32x4 (&acc)[2][2][4][2], const Unit& u, int wr, int wc, int fr, int fq) const {
        const int col0 = u.pn * 128 + wc * 32 + 8 * fq;
        const LAS float* epm = (const LAS float*)((const LAS unsigned char*)MS + (EPM_OFF - MISC_OFF));
        float rs[8];
#pragma unroll
        for (int q = 0; q < 8; ++q) { const int r = (q >> 2) * 128 + wr * 64 + (q & 3) * 16 + fr; rs[q] = epm[r] * (1.0f / 64.0f); }
        f32x4 vbg[2], vbu[2];
#pragma unroll
        for (int n = 0; n < 2; ++n) { vbg[n] = *(const LAS f32x4*)(epm + 256 + wc * 32 + 8 * fq + 4 * n); vbu[n] = *(const LAS f32x4*)(epm + 384 + wc * 32 + 8 * fq + 4 * n); }
        const int mbase = MS[MS_BASE + u.e];
        auto row8 = [&](int ai, int m) -> u32x2 {
            const float rsq = rs[ai * 4 + m], rsqc = rsq * SWC, rsqi = rsq * (1.0f / SWC); unsigned wq[2];
#pragma unroll
            for (int n = 0; n < 2; ++n) {
                f32x2 o2[2];
#pragma unroll
                for (int h = 0; h < 2; ++h) {
                    const f32x2 ag = (f32x2){acc[ai][0][m][n][2 * h], acc[ai][0][m][n][2 * h + 1]}, au = (f32x2){acc[ai][1][m][n][2 * h], acc[ai][1][m][n][2 * h + 1]};
                    const f32x2 bgv = (f32x2){vbg[n][2 * h], vbg[n][2 * h + 1]}, buv = (f32x2){vbu[n][2 * h], vbu[n][2 * h + 1]};
                    f32x2 gc = ag * rsqc + bgv * SWC, uc = au * rsqi + (buv + 1.0f) * (1.0f / SWC);
                    gc.x = fminf(gc.x, 7.0f * SWC); gc.y = fminf(gc.y, 7.0f * SWC);
                    uc.x = __builtin_amdgcn_fmed3f(uc.x, -6.0f / SWC, 8.0f / SWC); uc.y = __builtin_amdgcn_fmed3f(uc.y, -6.0f / SWC, 8.0f / SWC);
                    f32x2 t; t.x = __builtin_amdgcn_exp2f(-gc.x); t.y = __builtin_amdgcn_exp2f(-gc.y);
                    t = t + 1.0f; f32x2 sg; sg.x = __builtin_amdgcn_rcpf(t.x); sg.y = __builtin_amdgcn_rcpf(t.y);
                    o2[h] = uc * (gc * sg);
                }
                int w_ = 0; w_ = __builtin_amdgcn_cvt_pk_fp8_f32(o2[0].x, o2[0].y, w_, false); w_ = __builtin_amdgcn_cvt_pk_fp8_f32(o2[1].x, o2[1].y, w_, true); wq[n] = (unsigned)w_;
            }
            u32x2 w; w.x = wq[0]; w.y = wq[1]; return w; };
        const int colw = u.pn * 128 + wc * 32 + 16 * (fq >> 1);
#pragma unroll
        for (int ai = 0; ai < 2; ++ai)
#pragma unroll
            for (int mp = 0; mp < 2; ++mp) {
                const u32x2 wa = row8(ai, 2 * mp), wb = row8(ai, 2 * mp + 1);
                const auto sx = __builtin_amdgcn_permlane16_swap(wa.x, wb.x, false, false), sy = __builtin_amdgcn_permlane16_swap(wa.y, wb.y, false, false);
                u32x4 w; w.x = sx[0]; w.y = sy[0]; w.z = sx[1]; w.w = sy[1];
                const int r = ai * 128 + wr * 64 + (2 * mp + (fq & 1)) * 16 + fr;
                if (r < u.nrows) *(u32x4*)(mid + (size_t)(mbase + u.r0 + r) * DEXP + colw) = w;
            }
    }
};
struct EpiDownY {
    static constexpr bool PERM16 = true; static constexpr bool PREDMA = true;
    const LAS int* MS; const unsigned char* ws; const float* bd; unsigned char* Y;
    __device__ __forceinline__ void pre_dma(const Unit& u, int tid, int wid, LAS unsigned char* epm) const {
        const float* src;
        if (wid < 4) { const float* ent_gate = (const float*)(ws + WS_ENT + (size_t)NBIN * CAP * 4); const int rr = tid < u.nrows ? tid : u.nrows - 1; src = ent_gate + moe_idx(MS, u.e, u.r0 + rr); }
        else { src = bd + u.e * DMODEL + u.pn * 256 + (tid & 255); }
        __builtin_amdgcn_global_load_lds((const unsigned*)src, (LAS unsigned*)(epm + wid * 256), 4, 0, 0);
    }
    __device__ __forceinline__ void operator()(const f32x4 (&acc)[2][2][4][2], const Unit& u, int wr, int wc, int fr, int fq) const {
        const int col0 = u.pn * 256 + wc * 64 + 16 * fq;
        const LAS float* epm = (const LAS float*)((const LAS unsigned char*)MS + (EPM_OFF - MISC_OFF));
        float gate[8];
#pragma unroll
        for (int q = 0; q < 8; ++q) { const int r = (q >> 2) * 128 + wr * 64 + (q & 3) * 16 + fr; gate[q] = epm[r] * (1.0f / 64.0f); }
        f32x4 vb[2][2];
#pragma unroll
        for (int bj = 0; bj < 2; ++bj)
#pragma unroll
            for (int n = 0; n < 2; ++n) vb[bj][n] = *(const LAS f32x4*)(epm + 256 + wc * 64 + 16 * fq + 8 * bj + 4 * n) * 64.0f;
        const int mbase = MS[MS_BASE + u.e] + u.r0;
#pragma unroll
        for (int ai = 0; ai < 2; ++ai)
#pragma unroll
            for (int m = 0; m < 4; ++m) {
                const int r = ai * 128 + wr * 64 + m * 16 + fr; const float gt = gate[ai * 4 + m];
                u32x4 w;
                unsigned wq[4];
#pragma unroll
                for (int bj = 0; bj < 2; ++bj)
#pragma unroll
                    for (int n = 0; n < 2; ++n) { const f32x4 a = (acc[ai][bj][m][n] + vb[bj][n]) * gt;
                        int w0 = 0; w0 = __builtin_amdgcn_cvt_pk_fp8_f32(a[0], a[1], w0, false); w0 = __builtin_amdgcn_cvt_pk_fp8_f32(a[2], a[3], w0, true); wq[2 * bj + n] = (unsigned)w0; }
                w.x = wq[0]; w.y = wq[1]; w.z = wq[2]; w.w = wq[3];
                if (r < u.nrows) *(u32x4*)(Y + (size_t)(mbase + r) * DMODEL + col0) = w;
            }
    }
};

struct EpiNull {
    static constexpr bool PERM16 = false; static constexpr bool PREDMA = false;
    __device__ __forceinline__ void operator()(const f32x4 (&acc)[2][2][4][2], const Unit& u, int wr, int wc, int fr, int fq) const {
#pragma unroll
        for (int ai = 0; ai < 2; ++ai)
#pragma unroll
            for (int bj = 0; bj < 2; ++bj)
#pragma unroll
                for (int m = 0; m < 4; ++m) asm volatile("" :: "v"(acc[ai][bj][m][0]), "v"(acc[ai][bj][m][1]));
    }
};
namespace attn_body {
using bf16 = __hip_bfloat16;
using s16x4 = __attribute__((ext_vector_type(4))) short;
using f32x16 = __attribute__((ext_vector_type(16))) float;
constexpr int D = 64, NW = 8, QBLK = 32, QB = QBLK * NW, KVBLK = 64, NT = SEQ / KVBLK;
__device__ __forceinline__ int crow(int r, int hi) { return (r & 3) + 8 * (r >> 2) + 4 * hi; }
#define SBAR() __builtin_amdgcn_sched_barrier(0)
constexpr int NSLOT = 3, SLOTB = 8192;
constexpr int LDS_K = 0, LDS_V = NSLOT * SLOTB, LDS_WS = 2 * NSLOT * SLOTB, LDS_OST = LDS_WS + NW * 64 * 4, ATTN_LDS_BYTES = LDS_OST + NW * 4096;
__device__ __forceinline__ void glds16(const void* gsrc, unsigned lds_dst) { unsigned keep;
  asm volatile("s_mov_b32 %0, m0\n\ts_mov_b32 m0, %2\n\ts_nop 0\n\tglobal_load_lds_dwordx4 %1, off\n\ts_mov_b32 m0, %0" : "=&s"(keep) : "v"(gsrc), "s"(lds_dst) : "memory"); }
typedef float f32x2_t __attribute__((ext_vector_type(2))); typedef __bf16 bf16x2_t __attribute__((ext_vector_type(2)));
__device__ __forceinline__ unsigned cvtpk_s(float lo, float hi) { f32x2_t v = {lo, hi}; bf16x2_t b = __builtin_convertvector(v, bf16x2_t); return __builtin_bit_cast(unsigned, b); }
#define WAIT_BAR(N) asm volatile("s_waitcnt vmcnt(" #N ") lgkmcnt(0)\n\ts_barrier" ::: "memory")

__device__ __forceinline__ void qkt(f32x16& p0, f32x16& p1, const char* Kslot, const bf16x8* qr, const f32x16& negm, int r32, int hi) {
  const char* kb = Kslot + hi * 1024 + r32 * 16;
  #pragma unroll
  for (int d0 = 0; d0 < 4; ++d0) {
    const bf16x8 b0 = *reinterpret_cast<const bf16x8*>(kb + d0 * 2048);
    const bf16x8 b1 = *reinterpret_cast<const bf16x8*>(kb + d0 * 2048 + 512);
    if (d0 == 0) { p0 = __builtin_amdgcn_mfma_f32_32x32x16_bf16(b0, qr[0], negm, 0, 0, 0); p1 = __builtin_amdgcn_mfma_f32_32x32x16_bf16(b1, qr[0], negm, 0, 0, 0); }
    else { p0 = __builtin_amdgcn_mfma_f32_32x32x16_bf16(b0, qr[d0], p0, 0, 0, 0); p1 = __builtin_amdgcn_mfma_f32_32x32x16_bf16(b1, qr[d0], p1, 0, 0, 0); } }
}
typedef __attribute__((address_space(3))) const char* lds_cptr;
typedef short v4i16_t __attribute__((ext_vector_type(4)));
__device__ __forceinline__ void kload8(bf16x8* kf, lds_cptr kp) {
  kf[0] = *(const LAS bf16x8*)(kp);        kf[1] = *(const LAS bf16x8*)(kp + 512);
  kf[2] = *(const LAS bf16x8*)(kp + 2048); kf[3] = *(const LAS bf16x8*)(kp + 2560);
  kf[4] = *(const LAS bf16x8*)(kp + 4096); kf[5] = *(const LAS bf16x8*)(kp + 4608);
  kf[6] = *(const LAS bf16x8*)(kp + 6144); kf[7] = *(const LAS bf16x8*)(kp + 6656);
}
__device__ __forceinline__ void kload2(bf16x8* kf, lds_cptr kp, int j) { kf[2 * j] = *(const LAS bf16x8*)(kp + j * 2048); kf[2 * j + 1] = *(const LAS bf16x8*)(kp + j * 2048 + 512); }
__device__ __forceinline__ s16x4 vtr(lds_cptr p) { return __builtin_bit_cast(s16x4, __builtin_amdgcn_ds_read_tr16_b64_v4i16((LAS v4i16_t*)p)); }
__device__ __forceinline__ void pv(f32x16* o, int vb, bf16x8 pa0, bf16x8 pa1, bf16x8 pa2, bf16x8 pa3) {
  #pragma unroll
  for (int d0 = 0; d0 < 2; ++d0) { s16x4 lo[4], hi[4];
    #pragma unroll
    for (int ks = 0; ks < 4; ++ks) {
      asm volatile("ds_read_b64_tr_b16 %0,%1 offset:%c2" : "=&v"(lo[ks]) : "v"(vb), "i"(d0 * 4096 + ks * 1024) : "memory");
      asm volatile("ds_read_b64_tr_b16 %0,%1 offset:%c2" : "=&v"(hi[ks]) : "v"(vb), "i"(d0 * 4096 + ks * 1024 + 512) : "memory"); }
    asm volatile("s_waitcnt lgkmcnt(0)" ::: "memory"); SBAR();
    #define PK(k) (bf16x8){lo[k][0], lo[k][1], lo[k][2], lo[k][3], hi[k][0], hi[k][1], hi[k][2], hi[k][3]}
    o[d0] = __builtin_amdgcn_mfma_f32_32x32x16_bf16(pa0, PK(0), o[d0], 0, 0, 0);
    o[d0] = __builtin_amdgcn_mfma_f32_32x32x16_bf16(pa1, PK(1), o[d0], 0, 0, 0);
    o[d0] = __builtin_amdgcn_mfma_f32_32x32x16_bf16(pa2, PK(2), o[d0], 0, 0, 0);
    o[d0] = __builtin_amdgcn_mfma_f32_32x32x16_bf16(pa3, PK(3), o[d0], 0, 0, 0);
    #undef PK
  }
}

template <int THRL> __device__ __forceinline__ void attn_unit(const bf16* Qrows, const bf16* __restrict__ Kh, const bf16* __restrict__ Vh, bf16* Orows, int opitch, char* shm,
                                                              const int primed, const bf16* Qnext, const bf16* Knext, bf16x8 (&qc)[4]) {
  int tid_ = threadIdx.x; asm volatile("" : "+v"(tid_));
  const int tid = tid_, lane = tid & 63, r32 = lane & 31, hi = lane >> 5; const int wid = __builtin_amdgcn_readfirstlane(tid >> 6);
  const bf16* Qw = Qrows + (long)(wid * QBLK) * D;
  const unsigned lds0 = (unsigned)(uintptr_t)shm;
  float* wsf = (float*)(shm + LDS_WS) + wid * 64;
  const bf16* ksrc = Kh + (long)lane * D + wid * 8;
  const bf16* vsrc = Vh + (long)(16 * (wid & 3) + (lane >> 2)) * D + (wid >> 2) * 32 + (lane & 3) * 8;
  const unsigned kdst = lds0 + LDS_K + wid * 1024, vdst = lds0 + LDS_V + wid * 1024;
  #define DMA_K(t, slot) glds16(ksrc + (long)(t) * KVBLK * D, (unsigned)__builtin_amdgcn_readfirstlane(kdst + (slot)))
  #define DMA_V(t, slot) glds16(vsrc + (long)(t) * KVBLK * D, (unsigned)__builtin_amdgcn_readfirstlane(vdst + (slot)))
  const int vb0 = (int)(lds0 + LDS_V) + ((lane >> 4) & 1) * 32 + (lane & 3) * 8 + (4 * hi + ((lane & 15) >> 2)) * 64;
  const char* Kbase = shm + LDS_K; bf16x8 kf[8];
  const lds_cptr shm3 = (lds_cptr)shm; const lds_cptr kp0 = shm3 + LDS_K + hi * 1024 + r32 * 16; const lds_cptr vp0 = shm3 + LDS_V + ((lane >> 4) & 1) * 32 + (lane & 3) * 8 + (4 * hi + ((lane & 15) >> 2)) * 64;
  bf16x8 qr[4];
  if (!primed) {
    DMA_K(0, 0); DMA_V(0, 0); DMA_K(1, SLOTB);
    #pragma unroll
    for (int d0 = 0; d0 < 4; ++d0) qr[d0] = *reinterpret_cast<const bf16x8*>(&Qw[(long)r32 * D + d0 * 16 + hi * 8]);
  } else {
    DMA_V(0, 0);
    #pragma unroll
    for (int d0 = 0; d0 < 4; ++d0) qr[d0] = qc[d0];
  }
  float l_reg = 0.f; f32x16 o[2]; o[0] = f32x16{}; o[1] = f32x16{}; const f32x16 negm = f32x16{};
  #define START(P0, P1) do { _Pragma("unroll") for (int r = 0; r < 16; ++r) P0[r] = __builtin_amdgcn_exp2f(P0[r]); } while (0)
  #define RESC() do { } while (0)
  f32x16 pA0, pA1, pB0, pB1;
  int sl_prev = 0, sl_cur = 0, sl_next = SLOTB;
  #define ROT() do { sl_prev = sl_cur; sl_cur = sl_next; sl_next = (sl_next == (NSLOT - 1) * SLOTB) ? 0 : sl_next + SLOTB; } while (0)
  if (!primed) DMA_K(2, 2 * SLOTB);
  WAIT_BAR(3);
  qkt(pA0, pA1, Kbase, qr, negm, r32, hi); asm volatile("s_nop 15\n\ts_nop 7" : "+v"(pA0), "+v"(pA1));
  START(pA0, pA1);
  _Pragma("unroll") for (int r = 0; r < 16; ++r) pA1[r] = __builtin_amdgcn_exp2f(pA1[r]);
  WAIT_BAR(0);
  DMA_K(3, 0); DMA_V(1, SLOTB);
  ROT();
  kload8(kf, kp0 + sl_cur);
  WAIT_BAR(2);
  s16x4 vlo[8], vhi[8]; u32x4 pw0, pw1, pw2, pw3;
  #define PKW(P, B) cvtpk_s(P[B], P[B + 1])
  #define PAF(k) __builtin_bit_cast(bf16x8, pw##k)
  #define VFR(i) (bf16x8){vlo[i][0], vlo[i][1], vlo[i][2], vlo[i][3], vhi[i][0], vhi[i][1], vhi[i][2], vhi[i][3]}
  #define PIN(x) asm volatile("" : "+v"(x))
  #define MX3(a, b, c) __builtin_fmaxf(__builtin_fmaxf((a), (b)), (c))
  #define GAPA(MF, A0, A1, A2, A3, W0, W1, PW) do { MF; sacc += A0; sacc += A1; sacc += A2; sacc += A3; PIN(sacc); W0; W1; PIN(PW); SBAR(); } while (0)
  #define EX(v) __builtin_amdgcn_exp2f(v)
  #define GAPB(MF, X, B) do { MF; X[B] = EX(X[B]); X[B + 1] = EX(X[B + 1]); X[B + 2] = EX(X[B + 2]); X[B + 3] = EX(X[B + 3]); PIN(X); SBAR(); } while (0)
  #define VRD(i) do { vlo[i] = vtr(vp_ + (((i) >> 2) * 4096 + ((i) & 3) * 1024)); vhi[i] = vtr(vp_ + (((i) >> 2) * 4096 + ((i) & 3) * 1024 + 512)); } while (0)
  #define KRD(G, j) do { if (G) { kload2(kf, kp0 + sl_next, j); SBAR(); } } while (0)
  #define STEP(C0, C1, P0, P1, t, GK, GV, GL) do { SBAR(); \
    const lds_cptr vp_ = vp0 + sl_prev; \
    VRD(0); SBAR(); float sacc = (P0[0] + P0[1]); \
    GAPA(C0 = __builtin_amdgcn_mfma_f32_32x32x16_bf16(kf[0], qr[0], negm, 0, 0, 0), P0[2], P0[3], P0[4], P0[5],     pw0[0] = PKW(P0, 0), pw0[1] = PKW(P0, 2), pw0); \
    VRD(4); SBAR(); GAPA(C1 = __builtin_amdgcn_mfma_f32_32x32x16_bf16(kf[1], qr[0], negm, 0, 0, 0), P0[6], P0[7], P0[8], P0[9],     pw0[2] = PKW(P0, 4), pw0[3] = PKW(P0, 6), pw0); \
    VRD(1); SBAR(); GAPA(C0 = __builtin_amdgcn_mfma_f32_32x32x16_bf16(kf[2], qr[1], C0, 0, 0, 0),   P0[10], P0[11], P0[12], P0[13], pw1[0] = PKW(P0, 8), pw1[1] = PKW(P0, 10), pw1); \
    VRD(5); SBAR(); GAPA(C1 = __builtin_amdgcn_mfma_f32_32x32x16_bf16(kf[3], qr[1], C1, 0, 0, 0),   P0[14], P0[15], P1[0], P1[1],   pw1[2] = PKW(P0, 12), pw1[3] = PKW(P0, 14), pw1); \
    VRD(2); SBAR(); GAPA(C0 = __builtin_amdgcn_mfma_f32_32x32x16_bf16(kf[4], qr[2], C0, 0, 0, 0),   P1[2], P1[3], P1[4], P1[5],     pw2[0] = PKW(P1, 0), pw2[1] = PKW(P1, 2), pw2); \
    VRD(6); SBAR(); GAPA(C1 = __builtin_amdgcn_mfma_f32_32x32x16_bf16(kf[5], qr[2], C1, 0, 0, 0),   P1[6], P1[7], P1[8], P1[9],     pw2[2] = PKW(P1, 4), pw2[3] = PKW(P1, 6), pw2); \
    VRD(3); SBAR(); GAPA(C0 = __builtin_amdgcn_mfma_f32_32x32x16_bf16(kf[6], qr[3], C0, 0, 0, 0),   P1[10], P1[11], P1[12], P1[13], pw3[0] = PKW(P1, 8), pw3[1] = PKW(P1, 10), pw3); \
    VRD(7); SBAR(); GAPA(C1 = __builtin_amdgcn_mfma_f32_32x32x16_bf16(kf[7], qr[3], C1, 0, 0, 0),   P1[14], P1[15], 0.f, 0.f,       pw3[2] = PKW(P1, 12), pw3[3] = PKW(P1, 14), pw3); \
    l_reg += sacc; \
    if (GK) { DMA_K((t) + 3, sl_cur); } if (GV) { DMA_V((t) + 1, sl_next); } \
    SBAR(); \
    GAPB(o[0] = __builtin_amdgcn_mfma_f32_32x32x16_bf16(PAF(0), VFR(0), o[0], 0, 0, 0), C0, 0); \
    GAPB(o[1] = __builtin_amdgcn_mfma_f32_32x32x16_bf16(PAF(0), VFR(4), o[1], 0, 0, 0), C0, 4); \
    KRD(GL, 0); GAPB(o[0] = __builtin_amdgcn_mfma_f32_32x32x16_bf16(PAF(1), VFR(1), o[0], 0, 0, 0), C0, 8); \
    KRD(GL, 1); GAPB(o[1] = __builtin_amdgcn_mfma_f32_32x32x16_bf16(PAF(1), VFR(5), o[1], 0, 0, 0), C0, 12); \
    KRD(GL, 2); GAPB(o[0] = __builtin_amdgcn_mfma_f32_32x32x16_bf16(PAF(2), VFR(2), o[0], 0, 0, 0), C1, 0); \
    KRD(GL, 3); GAPB(o[1] = __builtin_amdgcn_mfma_f32_32x32x16_bf16(PAF(2), VFR(6), o[1], 0, 0, 0), C1, 4); \
    GAPB(o[0] = __builtin_amdgcn_mfma_f32_32x32x16_bf16(PAF(3), VFR(3), o[0], 0, 0, 0), C1, 8); \
    GAPB(o[1] = __builtin_amdgcn_mfma_f32_32x32x16_bf16(PAF(3), VFR(7), o[1], 0, 0, 0), C1, 12); \
    } while (0)
  int t = 1;
  for (; t + 5 < NT; t += 2) {
    STEP(pB0, pB1, pA0, pA1, t, true, true, true);     WAIT_BAR(2); RESC(); ROT();
    STEP(pA0, pA1, pB0, pB1, t + 1, true, true, true); WAIT_BAR(2); RESC(); ROT();
  }
  #define ENDW(tt) do { if ((tt) + 3 < NT) { WAIT_BAR(2); } else if ((tt) + 2 < NT) { WAIT_BAR(1); } else { WAIT_BAR(0); } } while (0)
  for (; t + 1 < NT; t += 2) {
    STEP(pB0, pB1, pA0, pA1, t, (t + 3 < NT), (t + 1 < NT), (t + 1 < NT));         ENDW(t);     RESC(); ROT();
    STEP(pA0, pA1, pB0, pB1, t + 1, (t + 4 < NT), (t + 2 < NT), (t + 2 < NT));     ENDW(t + 1); RESC(); ROT();
  }
  if (Knext) { const bf16* kn = Knext + (long)lane * D + wid * 8;
    glds16(kn, (unsigned)__builtin_amdgcn_readfirstlane(kdst)); glds16(kn + (long)KVBLK * D, (unsigned)__builtin_amdgcn_readfirstlane(kdst + SLOTB)); glds16(kn + (long)2 * KVBLK * D, (unsigned)__builtin_amdgcn_readfirstlane(kdst + 2 * SLOTB)); }
  STEP(pB0, pB1, pA0, pA1, NT - 1, false, false, false); RESC();
  { float sacc = pB0[0] + pB0[1]; _Pragma("unroll") for (int r = 2; r < 16; ++r) sacc += pB0[r]; _Pragma("unroll") for (int r = 0; r < 16; ++r) sacc += pB1[r]; l_reg += sacc;
    pw0 = (u32x4){PKW(pB0, 0), PKW(pB0, 2), PKW(pB0, 4), PKW(pB0, 6)}; pw1 = (u32x4){PKW(pB0, 8), PKW(pB0, 10), PKW(pB0, 12), PKW(pB0, 14)}; pw2 = (u32x4){PKW(pB1, 0), PKW(pB1, 2), PKW(pB1, 4), PKW(pB1, 6)}; pw3 = (u32x4){PKW(pB1, 8), PKW(pB1, 10), PKW(pB1, 12), PKW(pB1, 14)};
    SBAR(); pv(o, vb0 + sl_cur, PAF(0), PAF(1), PAF(2), PAF(3)); }
  if (Qnext) { const bf16* Qn = Qnext + (long)(wid * QBLK) * D;
    #pragma unroll
    for (int d0 = 0; d0 < 4; ++d0) qc[d0] = *reinterpret_cast<const bf16x8*>(&Qn[(long)r32 * D + d0 * 16 + hi * 8]); }
  else {
    #pragma unroll
    for (int d0 = 0; d0 < 4; ++d0) qc[d0] = bf16x8{}; }
  #undef PKW
  #undef PAF
  #undef VFR
  #undef PIN
  #undef MX3
  #undef GAPA
  #undef GAPB
  #undef EX
  #undef VRD
  #undef KRD
  #undef STEP
  #undef ENDW
  { auto rr = __builtin_amdgcn_permlane32_swap(__float_as_uint(l_reg), __float_as_uint(l_reg), false, false); l_reg = __uint_as_float(rr[0]) + __uint_as_float(rr[1]); }
  if (hi == 0) wsf[32 + r32] = l_reg; asm volatile("s_waitcnt lgkmcnt(0)" ::: "memory");
  float rli[16];
  #pragma unroll
  for (int r = 0; r < 16; ++r) rli[r] = __builtin_amdgcn_rcpf(wsf[32 + crow(r, hi)]);
  bf16* Ow = Orows + (long)(wid * QBLK) * opitch;
  { bf16* stg = (bf16*)(shm + LDS_OST) + wid * 2048;
    #pragma unroll
    for (int r = 0; r < 16; ++r) { const int orow = crow(r, hi);
      #pragma unroll
      for (int d0 = 0; d0 < 2; ++d0) stg[orow * 64 + d0 * 32 + r32] = __float2bfloat16(o[d0][r] * rli[r]); }
    asm volatile("s_waitcnt lgkmcnt(0)" ::: "memory");
    #pragma unroll
    for (int i = 0; i < 4; ++i) { const int row = i * 8 + (lane >> 3), ch = lane & 7; const u32x4 v = *(const u32x4*)(stg + row * 64 + ch * 8); *(u32x4*)(Ow + (long)row * opitch + ch * 8) = v; } }
  asm volatile("s_waitcnt lgkmcnt(0)\n\ts_barrier" ::: "memory");
  #undef DMA_K
  #undef DMA_V
  #undef START
  #undef RESC
  #undef ROT
}
template <int THRL> __device__ __forceinline__ void attn_unit_v128(const bf16* Qrows, const bf16* __restrict__ Kh, const bf16* __restrict__ Vh0, const bf16* __restrict__ Vh1, bf16* Orows, int opitch, char* shm,
                                                                   const int primed, const bf16* Qnext, const bf16* Knext, bf16x8 (&qc)[4]) {
  constexpr int L2_K = 0, L2_V = 3 * 8192, L2_WS = L2_V + 3 * 16384, L2_OST = L2_WS + NW * 64 * 4;
  const f32x16 zero16 = f32x16{};
  int tid_ = threadIdx.x; asm volatile("" : "+v"(tid_));
  const int tid = tid_, lane = tid & 63, r32 = lane & 31, hi = lane >> 5; const int wid = __builtin_amdgcn_readfirstlane(tid >> 6);
  const bf16* Qw = Qrows + (long)(wid * QBLK) * D;
  const unsigned lds0 = (unsigned)(uintptr_t)shm;
  float* wsf = (float*)(shm + L2_WS) + wid * 64;
  const bf16* ksrc = Kh + (long)lane * D + wid * 8;
  const long voff_ = (long)(16 * (wid & 3) + (lane >> 2)) * D + (wid >> 2) * 32 + (lane & 3) * 8;
  const bf16* vsrc = Vh0 + voff_; const bf16* vsrc1 = Vh1 + voff_;
  const unsigned kdst = lds0 + L2_K + wid * 1024, vdst = lds0 + L2_V + wid * 1024;
  #define DMA_K(t, slot) glds16(ksrc + (long)(t) * KVBLK * D, (unsigned)__builtin_amdgcn_readfirstlane(kdst + (slot)))
  #define DMA_V(t, slot) do { glds16(vsrc + (long)(t) * KVBLK * D, (unsigned)__builtin_amdgcn_readfirstlane(vdst + 2 * (slot))); \
                               glds16(vsrc1 + (long)(t) * KVBLK * D, (unsigned)__builtin_amdgcn_readfirstlane(vdst + 2 * (slot) + 8192)); } while (0)
  const char* Kbase = shm + L2_K; bf16x8 kf[8];
  const lds_cptr shm3 = (lds_cptr)shm; const lds_cptr kp0 = shm3 + L2_K + hi * 1024 + r32 * 16; const lds_cptr vp0 = shm3 + L2_V + ((lane >> 4) & 1) * 32 + (lane & 3) * 8 + (4 * hi + ((lane & 15) >> 2)) * 64;
  bf16x8 qr[4];
  if (!primed) {
    DMA_K(0, 0); DMA_V(0, 0); DMA_K(1, SLOTB);
    #pragma unroll
    for (int d0 = 0; d0 < 4; ++d0) qr[d0] = *reinterpret_cast<const bf16x8*>(&Qw[(long)r32 * D + d0 * 16 + hi * 8]);
  } else {
    DMA_V(0, 0);
    #pragma unroll
    for (int d0 = 0; d0 < 4; ++d0) qr[d0] = qc[d0];
  }
  float l_reg = 0.f; f32x16 o[4]; o[0] = f32x16{}; o[1] = f32x16{}; o[2] = f32x16{}; o[3] = f32x16{};
  #define START(P0, P1) do { _Pragma("unroll") for (int r = 0; r < 16; ++r) P0[r] = __builtin_amdgcn_exp2f(P0[r]); } while (0)
  #define RESC() do { } while (0)
  f32x16 pA0, pA1, pB0, pB1;
  int sl_prev = 0, sl_cur = 0, sl_next = SLOTB;
  #define ROT() do { sl_prev = sl_cur; sl_cur = sl_next; sl_next = (sl_next == (NSLOT - 1) * SLOTB) ? 0 : sl_next + SLOTB; } while (0)
  if (!primed) DMA_K(2, 2 * SLOTB);
  WAIT_BAR(4);
  { const f32x16 zero_ = f32x16{}; qkt(pA0, pA1, Kbase, qr, zero_, r32, hi); } asm volatile("s_nop 15\n\ts_nop 7" : "+v"(pA0), "+v"(pA1));
  START(pA0, pA1);
  _Pragma("unroll") for (int r = 0; r < 16; ++r) pA1[r] = __builtin_amdgcn_exp2f(pA1[r]);
  WAIT_BAR(0);
  DMA_K(3, 0); DMA_V(1, SLOTB);
  ROT();
  kload8(kf, kp0 + sl_cur);
  WAIT_BAR(3);
  s16x4 vlo[8], vhi[8]; u32x4 pw0, pw1, pw2, pw3;
  #define PKW(P, B) cvtpk_s(P[B], P[B + 1])
  #define PAF(k) __builtin_bit_cast(bf16x8, pw##k)
  #define VFR(i) (bf16x8){vlo[i][0], vlo[i][1], vlo[i][2], vlo[i][3], vhi[i][0], vhi[i][1], vhi[i][2], vhi[i][3]}
  #define PIN(x) asm volatile("" : "+v"(x))
  #define MX3(a, b, c) __builtin_fmaxf(__builtin_fmaxf((a), (b)), (c))
  #define GAPA(MF, A0, A1, A2, A3, W0, W1, PW) do { MF; sacc += A0; sacc += A1; sacc += A2; sacc += A3; PIN(sacc); W0; W1; PIN(PW); SBAR(); } while (0)
  #define EX(v) __builtin_amdgcn_exp2f(v)
  #define GAPB(MF, X, B) do { MF; X[B] = EX(X[B]); X[B + 1] = EX(X[B + 1]); PIN(X); SBAR(); } while (0)
  #define VRD(c) do { vlo[(c) & 7] = vtr(vp_ + (((c) & 3) * 4096 + ((c) >> 2) * 1024)); vhi[(c) & 7] = vtr(vp_ + (((c) & 3) * 4096 + ((c) >> 2) * 1024 + 512)); } while (0)
  #define KRD(G, j) do { if (G) { kload2(kf, kp0 + sl_next, j); SBAR(); } } while (0)
  #define PVM(c, X, B) GAPB(o[(c) & 3] = __builtin_amdgcn_mfma_f32_32x32x16_bf16(PAFI((c) >> 2), VFR((c) & 7), o[(c) & 3], 0, 0, 0), X, B)
  #define PAFI(k) ((k) == 0 ? PAF(0) : (k) == 1 ? PAF(1) : (k) == 2 ? PAF(2) : PAF(3))
  #define STEP(C0, C1, P0, P1, t, GK, GV, GL) do { SBAR(); \
    const lds_cptr vp_ = vp0 + 2 * sl_prev; \
    VRD(0); SBAR(); float sacc = (P0[0] + P0[1]); \
    GAPA(C0 = __builtin_amdgcn_mfma_f32_32x32x16_bf16(kf[0], qr[0], zero16, 0, 0, 0), P0[2], P0[3], P0[4], P0[5],     pw0[0] = PKW(P0, 0), pw0[1] = PKW(P0, 2), pw0); \
    VRD(1); SBAR(); GAPA(C1 = __builtin_amdgcn_mfma_f32_32x32x16_bf16(kf[1], qr[0], zero16, 0, 0, 0), P0[6], P0[7], P0[8], P0[9],     pw0[2] = PKW(P0, 4), pw0[3] = PKW(P0, 6), pw0); \
    VRD(2); SBAR(); GAPA(C0 = __builtin_amdgcn_mfma_f32_32x32x16_bf16(kf[2], qr[1], C0, 0, 0, 0),   P0[10], P0[11], P0[12], P0[13], pw1[0] = PKW(P0, 8), pw1[1] = PKW(P0, 10), pw1); \
    VRD(3); SBAR(); GAPA(C1 = __builtin_amdgcn_mfma_f32_32x32x16_bf16(kf[3], qr[1], C1, 0, 0, 0),   P0[14], P0[15], P1[0], P1[1],   pw1[2] = PKW(P0, 12), pw1[3] = PKW(P0, 14), pw1); \
    VRD(4); SBAR(); GAPA(C0 = __builtin_amdgcn_mfma_f32_32x32x16_bf16(kf[4], qr[2], C0, 0, 0, 0),   P1[2], P1[3], P1[4], P1[5],     pw2[0] = PKW(P1, 0), pw2[1] = PKW(P1, 2), pw2); \
    VRD(5); SBAR(); GAPA(C1 = __builtin_amdgcn_mfma_f32_32x32x16_bf16(kf[5], qr[2], C1, 0, 0, 0),   P1[6], P1[7], P1[8], P1[9],     pw2[2] = PKW(P1, 4), pw2[3] = PKW(P1, 6), pw2); \
    VRD(6); SBAR(); GAPA(C0 = __builtin_amdgcn_mfma_f32_32x32x16_bf16(kf[6], qr[3], C0, 0, 0, 0),   P1[10], P1[11], P1[12], P1[13], pw3[0] = PKW(P1, 8), pw3[1] = PKW(P1, 10), pw3); \
    VRD(7); SBAR(); GAPA(C1 = __builtin_amdgcn_mfma_f32_32x32x16_bf16(kf[7], qr[3], C1, 0, 0, 0),   P1[14], P1[15], 0.f, 0.f,       pw3[2] = PKW(P1, 12), pw3[3] = PKW(P1, 14), pw3); \
    l_reg += sacc; \
    if (GK) { DMA_K((t) + 3, sl_cur); } if (GV) { DMA_V((t) + 1, sl_next); } \
    SBAR(); \
    PVM(0, C0, 0);  VRD(8);  SBAR(); \
    PVM(1, C0, 2);  VRD(9);  SBAR(); \
    PVM(2, C0, 4);  VRD(10); SBAR(); \
    PVM(3, C0, 6);  VRD(11); SBAR(); \
    KRD(GL, 0); PVM(4, C0, 8);  VRD(12); SBAR(); \
    PVM(5, C0, 10); VRD(13); SBAR(); \
    KRD(GL, 1); PVM(6, C0, 12); VRD(14); SBAR(); \
    PVM(7, C0, 14); VRD(15); SBAR(); \
    KRD(GL, 2); PVM(8, C1, 0); \
    PVM(9, C1, 2); \
    KRD(GL, 3); PVM(10, C1, 4); \
    PVM(11, C1, 6); \
    PVM(12, C1, 8); \
    PVM(13, C1, 10); \
    PVM(14, C1, 12); \
    PVM(15, C1, 14); \
    } while (0)
  int t = 1;
  for (; t + 5 < NT; t += 2) {
    STEP(pB0, pB1, pA0, pA1, t, true, true, true);     WAIT_BAR(3); RESC(); ROT();
    STEP(pA0, pA1, pB0, pB1, t + 1, true, true, true); WAIT_BAR(3); RESC(); ROT();
  }
  #define ENDW(tt) do { if ((tt) + 3 < NT) { WAIT_BAR(3); } else if ((tt) + 2 < NT) { WAIT_BAR(2); } else { WAIT_BAR(0); } } while (0)
  for (; t + 1 < NT; t += 2) {
    STEP(pB0, pB1, pA0, pA1, t, (t + 3 < NT), (t + 1 < NT), (t + 1 < NT));         ENDW(t);     RESC(); ROT();
    STEP(pA0, pA1, pB0, pB1, t + 1, (t + 4 < NT), (t + 2 < NT), (t + 2 < NT));     ENDW(t + 1); RESC(); ROT();
  }
  if (Knext) { const bf16* kn = Knext + (long)lane * D + wid * 8;
    glds16(kn, (unsigned)__builtin_amdgcn_readfirstlane(kdst)); glds16(kn + (long)KVBLK * D, (unsigned)__builtin_amdgcn_readfirstlane(kdst + SLOTB)); glds16(kn + (long)2 * KVBLK * D, (unsigned)__builtin_amdgcn_readfirstlane(kdst + 2 * SLOTB)); }
  STEP(pB0, pB1, pA0, pA1, NT - 1, false, false, false); RESC();
  { float sacc = pB0[0] + pB0[1]; _Pragma("unroll") for (int r = 2; r < 16; ++r) sacc += pB0[r]; _Pragma("unroll") for (int r = 0; r < 16; ++r) sacc += pB1[r]; l_reg += sacc;
    pw0 = (u32x4){PKW(pB0, 0), PKW(pB0, 2), PKW(pB0, 4), PKW(pB0, 6)}; pw1 = (u32x4){PKW(pB0, 8), PKW(pB0, 10), PKW(pB0, 12), PKW(pB0, 14)}; pw2 = (u32x4){PKW(pB1, 0), PKW(pB1, 2), PKW(pB1, 4), PKW(pB1, 6)}; pw3 = (u32x4){PKW(pB1, 8), PKW(pB1, 10), PKW(pB1, 12), PKW(pB1, 14)};
    SBAR(); const lds_cptr vp_ = vp0 + 2 * sl_cur;
    _Pragma("unroll") for (int c = 0; c < 16; ++c) { const s16x4 lo_ = vtr(vp_ + ((c & 3) * 4096 + (c >> 2) * 1024)), hi_ = vtr(vp_ + ((c & 3) * 4096 + (c >> 2) * 1024 + 512));
      const bf16x8 vf_ = (bf16x8){lo_[0], lo_[1], lo_[2], lo_[3], hi_[0], hi_[1], hi_[2], hi_[3]};
      o[c & 3] = __builtin_amdgcn_mfma_f32_32x32x16_bf16(PAFI(c >> 2), vf_, o[c & 3], 0, 0, 0); } }
  if (Qnext) { const bf16* Qn = Qnext + (long)(wid * QBLK) * D;
    #pragma unroll
    for (int d0 = 0; d0 < 4; ++d0) qc[d0] = *reinterpret_cast<const bf16x8*>(&Qn[(long)r32 * D + d0 * 16 + hi * 8]); }
  else {
    #pragma unroll
    for (int d0 = 0; d0 < 4; ++d0) qc[d0] = bf16x8{}; }
  #undef PKW
  #undef PAF
  #undef VFR
  #undef PIN
  #undef MX3
  #undef GAPA
  #undef GAPB
  #undef EX
  #undef VRD
  #undef KRD
  #undef STEP
  #undef ENDW
  #undef PVM
  #undef PAFI
  { auto rr = __builtin_amdgcn_permlane32_swap(__float_as_uint(l_reg), __float_as_uint(l_reg), false, false); l_reg = __uint_as_float(rr[0]) + __uint_as_float(rr[1]); }
  if (hi == 0) wsf[32 + r32] = l_reg; asm volatile("s_waitcnt lgkmcnt(0)" ::: "memory");
  float rli[16];
  #pragma unroll
  for (int r = 0; r < 16; ++r) rli[r] = __builtin_amdgcn_rcpf(wsf[32 + crow(r, hi)]);
  bf16* Ow = Orows + (long)(wid * QBLK) * opitch;
  { bf16* stg = (bf16*)(shm + L2_OST) + wid * 2048;
    #pragma unroll
    for (int hf = 0; hf < 2; ++hf) {
      #pragma unroll
      for (int r = 0; r < 16; ++r) { const int orow = crow(r, hi);
        #pragma unroll
        for (int d0 = 0; d0 < 2; ++d0) stg[orow * 64 + d0 * 32 + r32] = __float2bfloat16(o[hf * 2 + d0][r] * rli[r]); }
      asm volatile("s_waitcnt lgkmcnt(0)" ::: "memory");
      #pragma unroll
      for (int i = 0; i < 4; ++i) { const int row = i * 8 + (lane >> 3), ch = lane & 7; const u32x4 v = *(const u32x4*)(stg + row * 64 + ch * 8); *(u32x4*)(Ow + (long)row * opitch + hf * 64 + ch * 8) = v; }
      asm volatile("s_waitcnt lgkmcnt(0)" ::: "memory");
    } }
  asm volatile("s_waitcnt lgkmcnt(0)\n\ts_barrier" ::: "memory");
  #undef DMA_K
  #undef DMA_V
  #undef START
  #undef RESC
  #undef ROT
}
#undef SBAR
#undef WAIT_BAR
}

struct P0Item { const float* src; const float* ks; unsigned char* dst; int ldw; int fp8; };
__device__ __forceinline__ void p0_load(const P0Item& I, f32x4 (&v)[8], float (&sc)[8], int lane) {
#pragma unroll
    for (int i = 0; i < 8; ++i) { const int kk = (lane >> 3) + 8 * i; v[i] = __builtin_nontemporal_load((const f32x4*)(I.src + (size_t)kk * I.ldw + 4 * (lane & 7))); sc[i] = I.ks ? I.ks[kk] : 1.0f; }
}
__device__ __forceinline__ void p0_process(const P0Item& I, const f32x4 (&v)[8], const float (&sc)[8], LAS float* scr, int lane) {
    const float mul = I.fp8 ? 64.0f : 1.0f;
#pragma unroll
    for (int i = 0; i < 8; ++i) { const int kk = (lane >> 3) + 8 * i; const f32x4 w = v[i] * (sc[i] * mul);
        LAS float* s = scr + kk * 33 + 4 * (lane & 7); s[0] = w[0]; s[1] = w[1]; s[2] = w[2]; s[3] = w[3]; }
    asm volatile("s_waitcnt lgkmcnt(0)" ::: "memory");
    const int c = lane & 7;
    if (I.fp8) {
#pragma unroll
        for (int j = 0; j < 4; ++j) { const int n = (lane >> 3) + 8 * j; const LAS float* s = scr + (8 * c) * 33 + n;
            u32x2 o; o.x = pk4_fp8(s[0 * 33], s[1 * 33], s[2 * 33], s[3 * 33]); o.y = pk4_fp8(s[4 * 33], s[5 * 33], s[6 * 33], s[7 * 33]);
            *(u32x2*)(I.dst + (size_t)n * KDIM + 8 * c) = o; }
    } else {
#pragma unroll
        for (int j = 0; j < 4; ++j) { const int n = (lane >> 3) + 8 * j; const LAS float* s = scr + (8 * c) * 33 + n;
            u32x4 o; o.x = cvt_pk_bf16(s[0 * 33], s[1 * 33]); o.y = cvt_pk_bf16(s[2 * 33], s[3 * 33]); o.z = cvt_pk_bf16(s[4 * 33], s[5 * 33]); o.w = cvt_pk_bf16(s[6 * 33], s[7 * 33]);
            *(u32x4*)(I.dst + (size_t)n * KDIM * 2 + 16 * c) = o; }
    }
    asm volatile("s_waitcnt lgkmcnt(0)" ::: "memory");
}
constexpr int P0_IN = 16 * 72, P0_OUT = 16 * 32, P0_GU = NEXP * 16 * 64, P0_DN = NEXP * 16 * 32, P0_NITEMS = P0_IN + P0_OUT + P0_GU + P0_DN;
__device__ __forceinline__ P0Item p0_decode(const Frame& F, int it) {
    P0Item I; int r = it;
    if (r < P0_IN) { const int kb = r / 72, nb = r % 72, pn = nb >> 3, bj = (nb >> 2) & 1, wc = nb & 3;
        I.src = F.in[I_WIN] + (size_t)(64 * kb) * NPROJ + 256 * pn + 64 * wc + 32 * bj; I.ldw = NPROJ; I.ks = F.in[I_N1G] + 64 * kb; I.fp8 = 0;
        I.dst = F.ws + WS_WIN + ((size_t)(32 * nb) * KDIM + 64 * kb) * 2; return I; }
    r -= P0_IN;
    if (r < P0_OUT) { const int kb = r / 32, nb = r % 32;
        I.src = F.in[I_WOUT] + (size_t)(64 * kb) * DMODEL + 32 * nb; I.ldw = DMODEL; I.ks = nullptr; I.fp8 = 0;
        I.dst = F.ws + WS_WOUT + ((size_t)(32 * nb) * KDIM + 64 * kb) * 2; return I; }
    r -= P0_OUT;
    if (r < P0_GU) { const int e = r >> 10, q = r & 1023, kb = q >> 6, nb = q & 63, pn = nb >> 3, bj = (nb >> 2) & 1, jb = nb & 3;
        I.src = (bj ? F.in[I_WU] : F.in[I_WG]) + (size_t)e * DMODEL * DEXP + (size_t)(64 * kb) * DEXP + 128 * pn + 32 * jb; I.ldw = DEXP; I.ks = F.in[I_N2G] + 64 * kb; I.fp8 = 1;
        I.dst = F.ws + WS_WGU + ((size_t)e * 2048 + 32 * nb) * KDIM + 64 * kb; return I; }
    r -= P0_GU;
    { const int e = r >> 9, q = r & 511, kb = q >> 5, nb = q & 31;
        I.src = F.in[I_WDN] + (size_t)e * DEXP * DMODEL + (size_t)(64 * kb) * DMODEL + 32 * nb; I.ldw = DMODEL; I.ks = nullptr; I.fp8 = 1;
        I.dst = F.ws + WS_WD + ((size_t)e * 1024 + 32 * nb) * KDIM + 64 * kb; return I; }
}
__device__ __forceinline__ void p0_convert_range(const Frame& F, int it0, int it1, int w, int nw, LAS float* scr, int lane) {
    int it = it0 + w;
    if (it < it1) {
        P0Item A = p0_decode(F, it), B = A; f32x4 va[8], vb[8]; float sa[8], sb[8];
        p0_load(A, va, sa, lane);
        for (;;) {
            const bool hb = it + nw < it1; if (hb) { B = p0_decode(F, it + nw); p0_load(B, vb, sb, lane); }
            p0_process(A, va, sa, scr, lane);
            if (!hb) break; it += nw;
            const bool ha = it + nw < it1; if (ha) { A = p0_decode(F, it + nw); p0_load(A, va, sa, lane); }
            p0_process(B, vb, sb, scr, lane);
            if (!ha) break; it += nw;
        }
    }
}
__device__ __forceinline__ void p0_prologue(Frame& F) {
    LAS float* scr = (LAS float*)(F.lds + F.wave * 16384);
    const int gw = F.vcu * NWAVES + F.wave, NGW = F.G * NWAVES, lane = F.lane;
    p0_convert_range(F, 0, P0_IN + P0_OUT, gw, NGW, scr, lane);
    { bf16_t* XN = (bf16_t*)(F.ws + WS_XN); float* sig = (float*)(F.ws + WS_SIG);
      for (int m = gw; m < MTOK; m += 2 * NGW) {
          const int m2 = m + NGW; const bool h2 = m2 < MTOK;
          const float* xr = F.in[I_X] + (size_t)m * DMODEL + 8 * lane; const float* xr2 = F.in[I_X] + (size_t)(h2 ? m2 : m) * DMODEL + 8 * lane;
          f32x4 v[4], w[4]; float s = 0.f, s2 = 0.f;
#pragma unroll
          for (int j = 0; j < 2; ++j) { v[2 * j] = __builtin_nontemporal_load((const f32x4*)(xr + 512 * j)); v[2 * j + 1] = __builtin_nontemporal_load((const f32x4*)(xr + 512 * j + 4));
                                        w[2 * j] = __builtin_nontemporal_load((const f32x4*)(xr2 + 512 * j)); w[2 * j + 1] = __builtin_nontemporal_load((const f32x4*)(xr2 + 512 * j + 4)); }
#pragma unroll
          for (int j = 0; j < 4; ++j) { s += (v[j].x * v[j].x + v[j].y * v[j].y) + (v[j].z * v[j].z + v[j].w * v[j].w); s2 += (w[j].x * w[j].x + w[j].y * w[j].y) + (w[j].z * w[j].z + w[j].w * w[j].w); }
          const float sg = sqrtf(wave_sum(s) * (1.0f / DMODEL) + EPS), sg2 = sqrtf(wave_sum(s2) * (1.0f / DMODEL) + EPS);
          const float rstd = 1.0f / sg, rstd2 = 1.0f / sg2;
          bf16_t* o8 = XN + (size_t)m * DMODEL + 8 * lane; bf16_t* o82 = XN + (size_t)m2 * DMODEL + 8 * lane;
#pragma unroll
          for (int j = 0; j < 2; ++j) { const f32x4 y0 = v[2 * j] * rstd, y1 = v[2 * j + 1] * rstd; u32x4 t; t.x = cvt_pk_bf16(y0.x, y0.y); t.y = cvt_pk_bf16(y0.z, y0.w); t.z = cvt_pk_bf16(y1.x, y1.y); t.w = cvt_pk_bf16(y1.z, y1.w); *(u32x4*)(o8 + 512 * j) = t; }
          if (lane == 0) sig[m] = sg;
          if (h2) {
#pragma unroll
              for (int j = 0; j < 2; ++j) { const f32x4 y0 = w[2 * j] * rstd2, y1 = w[2 * j + 1] * rstd2; u32x4 t; t.x = cvt_pk_bf16(y0.x, y0.y); t.y = cvt_pk_bf16(y0.z, y0.w); t.z = cvt_pk_bf16(y1.x, y1.y); t.w = cvt_pk_bf16(y1.z, y1.w); *(u32x4*)(o82 + 512 * j) = t; }
              if (lane == 0) sig[m2] = sg2; }
      } }
    if (blockIdx.x == 0 && F.tid < 64) { float* tab = (float*)(F.ws + WS_TAB); const int i = F.tid & 31;
        const float f = (F.tid < 32) ? powf(10000.0f, -(float)(2 * i) / 64.0f) : powf(10000.0f, -(float)(2 * (i & 15)) / 32.0f);
        tab[F.tid] = (float)((double)f * 0.15915494309189535); }
    { unsigned char* wr = F.ws + WS_WR; const float* rw = F.in[I_RW]; const float* g2 = F.in[I_N2G];
      for (int idx = gw * 64 + lane; idx < DMODEL * NEXP; idx += NGW * 64) { const int k = idx >> 5, e = idx & 31; const float w = rw[idx] * g2[k];
          const unsigned hi = cvt_pk_bf16(w, 0.f) & 0xffffu; const float rem = w - __uint_as_float(hi << 16); const unsigned lo = cvt_pk_bf16(rem, 0.f) & 0xffffu;
          const int off = e * 2048 + (((k >> 3) ^ (e & 15)) << 4) + (k & 7) * 2;
          *(bf16_t*)(wr + off) = (bf16_t)hi; *(bf16_t*)(wr + 65536 + off) = (bf16_t)lo; } }
    if (blockIdx.x == 0) {
        unsigned* ctl = (unsigned*)(F.ws + WS_CTL);
        { float* gnt = (float*)(F.ws + WS_GN);
          if (F.tid < 64) gnt[F.tid] = F.in[I_AQG][F.tid]; else if (F.tid < 128) gnt[F.tid] = F.in[I_AKG][F.tid - 64];
          else if (F.tid < 192) gnt[F.tid] = F.in[I_BQG][F.tid - 128]; else if (F.tid < 256) gnt[F.tid] = F.in[I_BKG][F.tid - 192]; }
        if (F.tid < NBIN) ctl[CW_BIN + BIN_STRIDE * F.tid] = 0u;
        if (F.tid >= 448) {
            const int i = F.tid - 448;
            const float d1 = wave_sum(F.in[I_LQ1][i] * F.in[I_LK1][i]), d2 = wave_sum(F.in[I_LQ2][i] * F.in[I_LK2][i]);
            if (i == 0) ((float*)ctl)[256] = expf(d1) - expf(d2) + LAM_INIT;
        }
    }
}

__device__ __forceinline__ void p2_attention(Frame& F, char* shm) {
    using abf = attn_body::bf16;
    const abf* QA = (const abf*)(F.ws + WS_QA); const abf* KA = (const abf*)(F.ws + WS_KA); const abf* VA = (const abf*)(F.ws + WS_VA);
    const abf* QB = (const abf*)(F.ws + WS_QB); const abf* KB = (const abf*)(F.ws + WS_KB); const abf* VB = (const abf*)(F.ws + WS_VB);
    abf* CAT = (abf*)(F.ws + WS_CAT); abf* OAPW = (abf*)(F.ws + WS_OAP) + (size_t)blockIdx.x * 131072;
    const size_t HS = (size_t)SEQ * 64;
    auto combine = [&](const abf* OAP, int b, int h, int qb) {
        const float lam = ((const float*)(F.ws + WS_CTL))[256];
        int ctid = threadIdx.x; asm volatile("" : "+v"(ctid));
        const int chunk = ctid & 15, rlo = ctid >> 4;
        const u32x4* p1 = (const u32x4*)((const bf16_t*)OAP + rlo * 128 + chunk * 8); const u32x4* p2 = (const u32x4*)((const bf16_t*)OAP + 32768 + rlo * 128 + chunk * 8);
        const float* sg = F.in[I_SUBG] + chunk * 8;
        const f32x4 g0 = *(const f32x4*)sg, g1 = *(const f32x4*)(sg + 4);
        u32x4 av[8], dv[8];
#pragma unroll
        for (int ps = 0; ps < 8; ++ps) { av[ps] = p1[ps * 512]; dv[ps] = p2[ps * 512]; }
        bf16_t* dst = (bf16_t*)CAT + ((size_t)b * SEQ + qb * 256 + rlo) * DMODEL + h * 128 + chunk * 8;
#pragma unroll
        for (int ps = 0; ps < 8; ++ps) {
            const unsigned aw[4] = {av[ps].x, av[ps].y, av[ps].z, av[ps].w}, dw[4] = {dv[ps].x, dv[ps].y, dv[ps].z, dv[ps].w};
            float ov[8]; float ss = 0.f;
#pragma unroll
            for (int q = 0; q < 4; ++q) { const float lo = bf_lo(aw[q]) - lam * bf_lo(dw[q]), hi2 = bf_hi(aw[q]) - lam * bf_hi(dw[q]); ov[q * 2] = lo; ov[q * 2 + 1] = hi2; ss += lo * lo + hi2 * hi2; }
            ss += xor1f(ss); ss += xor2f(ss); ss += xor4f(ss); ss += xor8f(ss);
            const float rs = __builtin_amdgcn_rsqf(ss * (1.0f / 128.0f) + EPS) * (1.0f - LAM_INIT);
            u32x4 w;
            w.x = cvt_pk_bf16(ov[0] * rs * g0[0], ov[1] * rs * g0[1]); w.y = cvt_pk_bf16(ov[2] * rs * g0[2], ov[3] * rs * g0[3]);
            w.z = cvt_pk_bf16(ov[4] * rs * g1[0], ov[5] * rs * g1[1]); w.w = cvt_pk_bf16(ov[6] * rs * g1[2], ov[7] * rs * g1[3]);
            *(u32x4*)(dst + (size_t)ps * 32 * DMODEL) = w;
        }
    };
    const int conv_slot = F.vcu % 6; int jn = 0; bool conv_done = false;
    int pend = 0, pb = 0, ph = 0, pqb = 0, pbuf = 0;
    bf16x8 qc[4]; int primed = 0;
#pragma unroll
    for (int d0 = 0; d0 < 4; ++d0) qc[d0] = bf16x8{};
    for (int J = F.vcu; J < 1536; J += F.G, ++jn) {
        if (jn == conv_slot) { conv_done = true; __syncthreads();
            { int t_ = threadIdx.x; asm volatile("" : "+v"(t_)); F.tid = t_; F.lane = t_ & 63; }
            p0_convert_range(F, P0_IN + P0_OUT, P0_NITEMS, F.vcu * NWAVES + F.wave, F.G * NWAVES, (LAS float*)(F.lds + F.wave * 16384), F.lane); __syncthreads(); }
        const bool isA = J < 512;
        int b, h = 0, qb, kvh = 0, g = 0;
        if (isA) { const int c = J >> 8, v = J & 255; b = v >> 5; const int w = (c << 5) | (v & 31); h = w >> 4; qb = w & 15; }
        else { const int ui = J - 512, i = ui >> 8, v = ui & 255; b = v >> 5; const int w = i * 32 + (v & 31); kvh = w >> 6; g = (w >> 4) & 3; qb = w & 15; }
        const abf* Qn1 = nullptr; const abf* Kn1 = nullptr;
        { const int Jn = J + F.G;
          if (Jn < 1536 && jn + 1 != conv_slot) {
              if (Jn < 512) { const int c = Jn >> 8, v = Jn & 255, bn = v >> 5, w = (c << 5) | (v & 31), hn = w >> 4, qbn = w & 15;
                  Qn1 = QA + (size_t)(bn * 8 + hn * 2) * HS + (size_t)qbn * 256 * 64; Kn1 = KA + (size_t)(bn * 8 + hn * 2) * HS; }
              else { const int ui = Jn - 512, i = ui >> 8, v = ui & 255, bn = v >> 5, w = i * 32 + (v & 31), kvhn = w >> 6, gn = (w >> 4) & 3, qbn = w & 15;
                  Qn1 = QB + (size_t)(bn * 8 + kvhn * 4 + gn) * HS + (size_t)qbn * 256 * 64; Kn1 = KB + (size_t)(bn * 2 + kvhn) * HS; } } }
        if (isA) {
            abf* OAP = OAPW + (size_t)(jn & 1) * 65536;
            if (pend && pbuf == (jn & 1)) { asm volatile("s_waitcnt vmcnt(0)" ::: "memory"); __syncthreads(); combine(OAPW + (size_t)pbuf * 65536, pb, ph, pqb); pend = 0; asm volatile("s_waitcnt vmcnt(0)" ::: "memory"); __syncthreads(); }
#pragma unroll 1
            for (int br = 0; br < 2; ++br) {
                const abf* Qn = br == 0 ? QA + (size_t)(b * 8 + h * 2 + 1) * HS + (size_t)qb * 256 * 64 : Qn1;
                const abf* Kn = br == 0 ? KA + (size_t)(b * 8 + h * 2 + 1) * HS : Kn1;
                attn_body::attn_unit_v128<8>(QA + (size_t)(b * 8 + h * 2 + br) * HS + (size_t)qb * 256 * 64, KA + (size_t)(b * 8 + h * 2 + br) * HS,
                                             VA + (size_t)(b * 8 + h * 2) * HS, VA + (size_t)(b * 8 + h * 2 + 1) * HS, OAP + br * 32768, 128, shm, primed, Qn, Kn, qc);
                primed = (Kn != nullptr);
                if (br == 0 && pend) { combine(OAPW + (size_t)pbuf * 65536, pb, ph, pqb); pend = 0; }
            }
            pend = 1; pb = b; ph = h; pqb = qb; pbuf = jn & 1;
        } else { const int qh = kvh * 4 + g;
            attn_body::attn_unit<8>(QB + (size_t)(b * 8 + qh) * HS + (size_t)qb * 256 * 64, KB + (size_t)(b * 2 + kvh) * HS, VB + (size_t)(b * 2 + kvh) * HS,
                                    CAT + ((size_t)b * SEQ + qb * 256) * DMODEL + 512 + qh * 64, DMODEL, shm, primed, Qn1, Kn1, qc);
            primed = (Kn1 != nullptr);
            if (pend) { combine(OAPW + (size_t)pbuf * 65536, pb, ph, pqb); pend = 0; }
        }
    }
    if (pend) { asm volatile("s_waitcnt vmcnt(0)" ::: "memory"); __syncthreads(); combine(OAPW + (size_t)pbuf * 65536, pb, ph, pqb); pend = 0; }
    if (!conv_done) { __syncthreads(); { int t_ = threadIdx.x; asm volatile("" : "+v"(t_)); F.tid = t_; F.lane = t_ & 63; } p0_convert_range(F, P0_IN + P0_OUT, P0_NITEMS, F.vcu * NWAVES + F.wave, F.G * NWAVES, (LAS float*)(F.lds + F.wave * 16384), F.lane); __syncthreads(); }
}

__device__ __forceinline__ void p4_fill(Frame& F) {
    int t_ = threadIdx.x; asm volatile("" : "+v"(t_));
    const f32x4* src = (const f32x4*)(F.ws + WS_WR); LAS f32x4* d = (LAS f32x4*)F.lds; for (int i = t_; i < 8192; i += NTHR) d[i] = src[i];
}
__device__ __forceinline__ void p4_route(Frame& F, const bool filled) {
    LAS int* tk_e = (LAS int*)(F.lds + MISC_OFF);
    LAS float* tk_g = (LAS float*)(F.lds + MISC_OFF + 2048);
    LAS int* tk_r = (LAS int*)(F.lds + MISC_OFF + 4096);
    LAS int* lcnt = (LAS int*)(F.lds + MISC_OFF + 6144);
    LAS int* lbase = (LAS int*)(F.lds + MISC_OFF + 6656);
    LAS float* tk_s = (LAS float*)(F.lds + MISC_OFF + 7168);
    const int tid = F.tid, lane = F.lane, wave = F.wave;
    if (!filled) p4_fill(F);
    if (tid < NBIN) lcnt[tid] = 0;
    __syncthreads();
    const bf16_t* x1b = (const bf16_t*)(F.ws + WS_X1B); const float* rb = F.in[I_RB]; int* tokpos = (int*)(F.ws + WS_TP);
    float* rstd_tok = (float*)(F.ws + WS_RSTD); unsigned* gcnt = (unsigned*)(F.ws + WS_CTL);
    int* ent_tok = (int*)(F.ws + WS_ENT); float* ent_gate = (float*)(F.ws + WS_ENT + (size_t)NBIN * CAP * 4);
    using attn_body::f32x16;
    const int e = lane & 31, hi = lane >> 5;
    const float myb = rb[e];
    for (int ch = F.vcu; ch < MTOK / 128; ch += F.G) {
        const int t0 = ch * 128 + wave * 16;
        const bf16_t* xrow = x1b + (size_t)(t0 + (lane & 15)) * DMODEL + 8 * hi;
        const LAS unsigned char* wb = F.lds + e * 2048;
        f32x16 ah = f32x16{}, al = f32x16{}; f32x2 ss2 = (f32x2){0.f, 0.f};
        auto ldx = [&](u32x4 (&v)[8], int k0) {
#pragma unroll
            for (int j = 0; j < 8; ++j) v[j] = *(const u32x4*)(xrow + 16 * (k0 + j)); };
        auto mma8 = [&](const u32x4 (&v)[8], int k0) {
#pragma unroll
            for (int j = 0; j < 8; ++j) {
                const int c = 2 * (k0 + j) + hi;
                const bf16x8 bh = *(const LAS bf16x8*)(wb + ((c ^ (e & 15)) << 4)), bl = *(const LAS bf16x8*)(wb + 65536 + ((c ^ (e & 15)) << 4));
                const bf16x8 a = __builtin_bit_cast(bf16x8, v[j]);
                ah = __builtin_amdgcn_mfma_f32_32x32x16_bf16(a, bh, ah, 0, 0, 0);
                al = __builtin_amdgcn_mfma_f32_32x32x16_bf16(a, bl, al, 0, 0, 0);
                const unsigned aw[4] = {v[j].x, v[j].y, v[j].z, v[j].w};
#pragma unroll
                for (int q = 0; q < 4; ++q) { const f32x2 w = (f32x2){bf_lo(aw[q]), bf_hi(aw[q])}; ss2 += w * w; }
            } };
        u32x4 av[8], bv8[8];
        ldx(av, 0);
#pragma unroll 1
        for (int k0 = 0; k0 < 64; k0 += 16) {
            ldx(bv8, k0 + 8);
            mma8(av, k0);
            if (k0 + 16 < 64) ldx(av, k0 + 16);
            mma8(bv8, k0 + 8);
        }
        float ssum = ss2.x + ss2.y; ssum = sum32f(ssum);
        const float rstd_l = 1.0f / sqrtf(ssum * (1.0f / DMODEL) + EPS);
        if (lane < 16) { tk_s[wave * 16 + lane] = rstd_l; rstd_tok[t0 + lane] = rstd_l; }
        asm volatile("s_waitcnt lgkmcnt(0)" ::: "memory");
        float val[8];
#pragma unroll
        for (int q = 0; q < 8; ++q) val[q] = (ah[q] + al[q]) * tk_s[wave * 16 + attn_body::crow(q, hi)] + myb;
        int se[8][4]; float sv[8][4]; unsigned key[8];
#pragma unroll
        for (int q = 0; q < 8; ++q) { unsigned u = __float_as_uint(val[q]); u = (u & 0x80000000u) ? ~u : (u | 0x80000000u); key[q] = (u & ~31u) | (unsigned)(31 - e); }
#pragma unroll
        for (int k = 0; k < 4; ++k)
#pragma unroll
            for (int q = 0; q < 8; ++q) {
                unsigned m = key[q], o;
                o = (unsigned)dppi<0xB1>((int)m); m = m > o ? m : o; o = (unsigned)xor2i((int)m); m = m > o ? m : o; o = (unsigned)xor4i((int)m); m = m > o ? m : o;
                o = (unsigned)xor8i((int)m); m = m > o ? m : o; o = (unsigned)xor16i((int)m, lane); m = m > o ? m : o;
                se[q][k] = 31 - (int)(m & 31u);
                unsigned u = m & ~31u; u = (u & 0x80000000u) ? (u & 0x7fffffffu) : ~u;
                sv[q][k] = __uint_as_float(u);
                if (key[q] == m) key[q] = 0u;
            }
        if (e == 0) {
#pragma unroll
            for (int q = 0; q < 8; ++q) {
                const int lt = wave * 16 + attn_body::crow(q, hi);
                const float e1 = __expf(sv[q][1] - sv[q][0]), e2 = __expf(sv[q][2] - sv[q][0]), e3 = __expf(sv[q][3] - sv[q][0]); const float inv = 1.0f / (1.0f + e1 + e2 + e3);
                tk_e[lt * 4 + 0] = se[q][0]; tk_e[lt * 4 + 1] = se[q][1]; tk_e[lt * 4 + 2] = se[q][2]; tk_e[lt * 4 + 3] = se[q][3];
                tk_g[lt * 4 + 0] = inv; tk_g[lt * 4 + 1] = e1 * inv; tk_g[lt * 4 + 2] = e2 * inv; tk_g[lt * 4 + 3] = e3 * inv;
            }
        }
        __syncthreads();
        const int mybin = tk_e[tid] * 4 + (tid & 3);
        tk_r[tid] = __hip_atomic_fetch_add(&lcnt[mybin], 1, __ATOMIC_RELAXED, __HIP_MEMORY_SCOPE_WORKGROUP);
        __syncthreads();
        if (tid < NBIN) { const int c = lcnt[tid]; lbase[tid] = c ? (int)atomicAdd(&gcnt[CW_BIN + BIN_STRIDE * tid], (unsigned)c) : 0; lcnt[tid] = 0; }
        __syncthreads();
        { const int pos = lbase[mybin] + tk_r[tid]; const size_t idx = (size_t)mybin * CAP + pos; ent_tok[idx] = ch * 128 + (tid >> 2); ent_gate[idx] = tk_g[tid]; ent_gate[(size_t)NBIN * CAP + idx] = tk_s[tid >> 2]; tokpos[ch * 512 + tid] = (mybin << 16) | pos; }
        __syncthreads();
    }
}

__device__ __forceinline__ void p7_combine(Frame& F) {
    const int gw = F.vcu * NWAVES + F.wave, NGW = F.G * NWAVES, lane = F.lane;
    const int* tokpos = (const int*)(F.ws + WS_TP); const unsigned char* Y = F.ws + WS_Y; const bf16_t* x1b = (const bf16_t*)(F.ws + WS_X1B);
    for (int t = gw; t < MTOK; t += NGW) {
        const int4 tp = *(const int4*)(tokpos + 4 * t);
        const int tpv[4] = {tp.x, tp.y, tp.z, tp.w};
        size_t row[4];
#pragma unroll
        for (int k = 0; k < 4; ++k) { const int bin = tpv[k] >> 16, pos = tpv[k] & 0xffff, e = bin >> 2; row[k] = (size_t)(F.MS[MS_BASE + e] + F.MS[MS_CUM + bin] + pos); }
        u32x2 xb[4]; unsigned y[4][4];
#pragma unroll
        for (int j = 0; j < 4; ++j) xb[j] = __builtin_nontemporal_load((const u32x2*)(x1b + (size_t)t * DMODEL) + lane + 64 * j);
#pragma unroll
        for (int k = 0; k < 4; ++k)
#pragma unroll
            for (int j = 0; j < 4; ++j) y[k][j] = __builtin_nontemporal_load((const unsigned*)(Y + row[k] * DMODEL) + lane + 64 * j);
        f32x4* op = (f32x4*)(F.out + (size_t)t * DMODEL) + lane;
#pragma unroll
        for (int j = 0; j < 4; ++j) {
            f32x4 v = (f32x4){bf_lo(xb[j].x), bf_hi(xb[j].x), bf_lo(xb[j].y), bf_hi(xb[j].y)};
#pragma unroll
            for (int k = 0; k < 4; ++k) { const f32x2 lo = __builtin_amdgcn_cvt_pk_f32_fp8((int)y[k][j], false), hi = __builtin_amdgcn_cvt_pk_f32_fp8((int)y[k][j], true); v += (f32x4){lo.x, lo.y, hi.x, hi.y}; }
            __builtin_nontemporal_store(v, op + 64 * j);
        }
    }
}

__device__ __forceinline__ void moe_setup(Frame& F, int mode) {
    const unsigned* gcnt = (const unsigned*)(F.ws + WS_CTL);
    __syncthreads();
    if (F.tid < 64) {
        const int e = F.tid & 31;
        const unsigned* gb = gcnt + CW_BIN + BIN_STRIDE * 4 * e;
        const int c0 = (int)__hip_atomic_load(gb, RLX_AGENT), c1 = (int)__hip_atomic_load(gb + BIN_STRIDE, RLX_AGENT), c2 = (int)__hip_atomic_load(gb + 2 * BIN_STRIDE, RLX_AGENT), c3 = (int)__hip_atomic_load(gb + 3 * BIN_STRIDE, RLX_AGENT);
        const int ne = c0 + c1 + c2 + c3;
        const int nsel = mode < 0 ? ne : (mode == 0 ? c0 : mode == 1 ? c1 : mode == 2 ? c2 : c3);
        const int nt = (nsel + 255) >> 8;
        int sb = ne, st = nt;
#pragma unroll
        for (int o = 1; o < 32; o <<= 1) { const int tb = __shfl_up(sb, o, 32), tt = __shfl_up(st, o, 32); if (e >= o) { sb += tb; st += tt; } }
        if (F.tid < 32) {
            F.MS[MS_CNT + 4 * e] = c0; F.MS[MS_CNT + 4 * e + 1] = c1; F.MS[MS_CNT + 4 * e + 2] = c2; F.MS[MS_CNT + 4 * e + 3] = c3;
            F.MS[MS_CUM + 4 * e] = 0; F.MS[MS_CUM + 4 * e + 1] = c0; F.MS[MS_CUM + 4 * e + 2] = c0 + c1; F.MS[MS_CUM + 4 * e + 3] = c0 + c1 + c2; F.MS[MS_NE + e] = ne;
            F.MS[MS_ADJ + 4 * e] = (4 * e) * CAP; F.MS[MS_ADJ + 4 * e + 1] = (4 * e + 1) * CAP - c0; F.MS[MS_ADJ + 4 * e + 2] = (4 * e + 2) * CAP - (c0 + c1); F.MS[MS_ADJ + 4 * e + 3] = (4 * e + 3) * CAP - (c0 + c1 + c2);
            F.MS[MS_BASE + e] = sb - ne; F.MS[MS_TILE + e] = st - nt;
            if (e == NEXP - 1) { F.MS[MS_BASE + NEXP] = sb; F.MS[MS_TILE + NEXP] = st; }
            for (int rt = st - nt; rt < st; ++rt) F.MS[MS_TEXP + rt] = e;
        }
    }
    __syncthreads();
}

struct Args { const float* in[22]; float* out; unsigned char* ws; int ph_lo, ph_hi, coop, pad; };
constexpr int NPHASE = 8;
#ifndef PHM
#define PHM 0xff
#endif
#define PHON(k) (((PHM) >> (k)) & 1)
#ifndef REP_PH
#define REP_PH -1
#endif
#define REPEAT(k) for (int rep_ = 0; rep_ < ((REP_PH) == (k) ? 2 : 1); ++rep_)

__global__ void __launch_bounds__(NTHR, 2) hymba_fwd(Args args) {
    __builtin_assume(__builtin_amdgcn_workitem_id_y() == 0); __builtin_assume(__builtin_amdgcn_workitem_id_z() == 0);
    extern __shared__ __attribute__((aligned(16))) unsigned char lds[];
    Frame F;
    F.lds = (LAS unsigned char*)lds; F.MS = (LAS int*)(F.lds + MISC_OFF);
    F.tid = threadIdx.x; F.lane = F.tid & 63; F.wave = __builtin_amdgcn_readfirstlane(F.tid >> 6);
    F.G = gridDim.x; { const int bx = blockIdx.x; F.vcu = (F.G % 8 == 0) ? (bx % 8) * (F.G / 8) + bx / 8 : bx; }
    F.ws = args.ws; F.out = args.out;
#pragma unroll
    for (int i = 0; i < 22; ++i) F.in[i] = args.in[i];
    const int lo = args.ph_lo, hi = args.ph_hi;
    XcdBarrier bar; bar.bar = nullptr; bar.x = 0; bar.st = nullptr;
    if (args.coop) {
        if (F.tid < 2) F.MS[MS_BARST + F.tid] = 0;
        __syncthreads();
        bar = xcd_barrier_post((unsigned*)(F.ws + WS_CTL) + CW_BAR, (volatile LAS unsigned*)(F.MS + MS_BARST));
    }
#define FRESH() do { int t_ = threadIdx.x; asm volatile("" : "+v"(t_)); F.tid = t_; F.lane = t_ & 63; } while (0)
#define IN(k) (lo <= (k) && (k) < hi)
#ifndef USE_CG_SYNC0
#define USE_CG_SYNC0 0
#endif
#define SEAM(k) do { if (IN(k) && IN((k) + 1) && args.coop) { if (USE_CG_SYNC0 && (k) == 0) cg::this_grid().sync(); else xcd_barrier(bar); } } while (0)

    REPEAT(0) { if ((REP_PH) == 0 && rep_ == 1) xcd_barrier(bar); FRESH(); if (PHON(0) && IN(0)) p0_prologue(F); }
    SEAM(0);
    REPEAT(1) { if ((REP_PH) == 1 && rep_ == 1) xcd_barrier(bar);
      FRESH(); if (PHON(1) && IN(1)) {
        pg8::DenseOrder S; S.init(F.ws + WS_WIN, MTOK, NPROJ, F.G, (int)blockIdx.x);
        { LAS float* tb = (LAS float*)(F.lds + EPM_OFF);
          if (F.tid < 256) tb[F.tid] = ((const float*)(F.ws + WS_GN))[F.tid]; else if (F.tid < 320) tb[F.tid] = ((const float*)(F.ws + WS_TAB))[F.tid - 256];
          __syncthreads(); }
        EpiInProj E{F.ws, (const LAS float*)(F.lds + EPM_OFF)};
        pg8::gemm_phase<false>(F.lds, (const char*)(F.ws + WS_XN), S, E);
    } }
    SEAM(1);
    REPEAT(2) { if ((REP_PH) == 2 && rep_ == 1) xcd_barrier(bar); FRESH(); if (PHON(2) && IN(2)) p2_attention(F, (char*)lds); }
    SEAM(2);
    REPEAT(3) { if ((REP_PH) == 3 && rep_ == 1) xcd_barrier(bar);
      FRESH(); if (PHON(3) && IN(3)) {
        pg8::DenseOrder S; S.init(F.ws + WS_WOUT, MTOK, DMODEL, F.G, (int)blockIdx.x);
        EpiOutProj E{(const bf16_t*)(F.ws + WS_XN), (const float*)(F.ws + WS_SIG), (bf16_t*)(F.ws + WS_X1B), F.ws + WS_X18};
        pg8::gemm_phase<false>(F.lds, (const char*)(F.ws + WS_CAT), S, E);
        if (PHON(4) && IN(4)) p4_fill(F);
    } }
    SEAM(3);
    FRESH(); if (PHON(4) && IN(4)) p4_route(F, PHON(3) && IN(3));
    SEAM(4);
    REPEAT(5) { if ((REP_PH) == 5 && rep_ == 1) xcd_barrier(bar);
      FRESH(); if (PHON(5) && IN(5)) {
        moe_setup(F, -1);
        MoeUpOrder S{F.MS, F.ws, (const char*)(F.ws + WS_WGU), F.G, F.vcu};
        EpiSwiglu E{F.MS, F.ws, F.in[I_BG], F.in[I_BU], F.ws + WS_MID};
        pg8::gemm_phase<true>(F.lds, (const char*)(F.ws + WS_X18), S, E);
    } }
    SEAM(5);
    REPEAT(6) { if ((REP_PH) == 6 && rep_ == 1) xcd_barrier(bar);
      FRESH(); if (PHON(6) && IN(6)) {
        if (!IN(5)) moe_setup(F, -1);
        MoeDownOrder S{F.MS, (const char*)(F.ws + WS_WD), F.G, F.vcu};
        EpiDownY E{F.MS, F.ws, F.in[I_BD], F.ws + WS_Y};
        pg8::gemm_phase<true>(F.lds, (const char*)(F.ws + WS_MID), S, E);
    } }
    SEAM(6);
    FRESH(); if (PHON(7) && IN(7)) { if (!IN(5) && !IN(6)) moe_setup(F, -1); p7_combine(F); }
#undef IN
#undef SEAM
}

#ifndef N_LAUNCH_MODE
#define N_LAUNCH_MODE 1
#endif
extern "C" void kernel_launch(void* const* d_in, const int* in_sizes, int n_in, void* d_out, int out_size, void* d_ws, size_t ws_size, hipStream_t stream) {
    static int grid = 0;
    if (grid == 0) {
        if (n_in != 22 || out_size != MTOK * DMODEL || ws_size < WS_END) { fprintf(stderr, "kernel_launch: unexpected shapes (n_in %d out %d ws %zu)\n", n_in, out_size, ws_size); grid = -1; return; }
        int dev = 0, cus = 0, per_cu = 0;
        hipGetDevice(&dev); hipDeviceGetAttribute(&cus, hipDeviceAttributeMultiprocessorCount, dev);
        hipFuncSetAttribute((const void*)hymba_fwd, hipFuncAttributeMaxDynamicSharedMemorySize, LDS_BYTES);
        hipOccupancyMaxActiveBlocksPerMultiprocessor(&per_cu, (const void*)hymba_fwd, NTHR, LDS_BYTES);
        if (per_cu < 1) { fprintf(stderr, "kernel_launch: occupancy query says %d blocks/CU\n", per_cu); per_cu = 1; }
        (void)hipGetLastError();
        grid = cus < 256 ? cus : 256;
    }
    if (grid < 0) return;
    (void)hipMemsetAsync((char*)d_ws + WS_CTL, 0, CTL_ZERO_BYTES, stream);
    Args a{};
    for (int i = 0; i < 22; ++i) a.in[i] = (const float*)d_in[i];
    a.out = (float*)d_out; a.ws = (unsigned char*)d_ws;
#if N_LAUNCH_MODE == 1
    a.ph_lo = 0; a.ph_hi = NPHASE; a.coop = 1;
    void* kargs[] = {&a};
    hipError_t e = hipLaunchCooperativeKernel((const void*)hymba_fwd, dim3(grid), dim3(NTHR), kargs, LDS_BYTES, stream);
    if (e != hipSuccess) fprintf(stderr, "cooperative launch failed: %s (grid %d)\n", hipGetErrorString(e), grid);
#else
    for (int p = 0; p < NPHASE; ++p) {
        a.ph_lo = p; a.ph_hi = p + 1; a.coop = 0;
        hipLaunchKernelGGL(hymba_fwd, dim3(grid), dim3(NTHR), LDS_BYTES, stream, a);
    }
#endif
}
```

```cpp
#include <hip/hip_runtime.h>
#include <hip/hip_bf16.h>
#include <hip/hip_cooperative_groups.h>
#include <cstdio>
#include <cstdint>
#include <cmath>
namespace cg = cooperative_groups;

#define LAS __attribute__((address_space(3)))
#define GAS __attribute__((address_space(1)))
typedef unsigned short bf16_t;
typedef short bf16x8 __attribute__((ext_vector_type(8)));
typedef float f32x4 __attribute__((ext_vector_type(4)));
typedef float f32x2 __attribute__((ext_vector_type(2)));
typedef unsigned u32x4 __attribute__((ext_vector_type(4)));
typedef unsigned u32x2 __attribute__((ext_vector_type(2)));

constexpr int BATCH = 8, SEQ = 4096, DMODEL = 1024, MTOK = BATCH * SEQ;
constexpr int NPROJ = 2304, KDIM = 1024;
constexpr int NEXP = 32, TOPK = 4, DEXP = 1024, NBIN = NEXP * TOPK, CAP = MTOK;
constexpr float EPS = 1e-6f;
constexpr float C2 = 0.125f * 1.4426950408889634f;
constexpr float LAM_INIT = 0.2f;
constexpr int NWAVES = 8, NTHR = 512;

constexpr size_t MiB = 1u << 20;
constexpr size_t WS_CTL = 0;
constexpr int CW_BAR = 1024; constexpr size_t CTL_ZERO_BYTES = 65536;
constexpr size_t WS_TAB = 1 * MiB;
constexpr size_t WS_WR = 3 * MiB;
constexpr size_t WS_RSTD = 3 * MiB + 128 * 1024;
constexpr size_t WS_GN = 3 * MiB + 256 * 1024;
constexpr size_t WS_WIN = 4 * MiB;
constexpr size_t WS_WOUT = 9 * MiB;
constexpr size_t WS_TP = 3 * MiB + 512 * 1024;
constexpr size_t WS_WD = 11 * MiB;
constexpr size_t WS_ENT = 43 * MiB;
constexpr size_t WS_MID = 91 * MiB;
constexpr size_t WS_XN = WS_MID, WS_CAT = WS_MID + 64 * MiB;
constexpr size_t WS_OAP = 459 * MiB;
constexpr size_t WS_SIG = 2 * MiB;
constexpr size_t WS_Y = 219 * MiB;
constexpr size_t WS_X1B = 347 * MiB;
constexpr size_t WS_WGU = WS_Y;
constexpr size_t WS_X18 = WS_Y + 64 * MiB;
constexpr size_t WS_QA = WS_Y + 96 * MiB, WS_KA = WS_QA + 32 * MiB, WS_VA = WS_QA + 64 * MiB, WS_QB = WS_QA + 96 * MiB, WS_KB = WS_QA + 128 * MiB, WS_VB = WS_QA + 136 * MiB;
constexpr size_t WS_END = 523 * MiB;

constexpr int RING_BYTES = 131072, MISC_OFF = RING_BYTES, LDS_BYTES = 147456;
constexpr int MS_CNT = 0, MS_NE = 128, MS_BASE = 160, MS_TILE = 200, MS_CUM = 256, MS_ADJ = 384;
constexpr int MS_TEXP = 512;
constexpr int EPM_OFF = 131072 + 12288;
constexpr int MS_BARST = 2048;

#define RLX_AGENT __ATOMIC_RELAXED, __HIP_MEMORY_SCOPE_AGENT
__device__ __forceinline__ unsigned cvt_pk_bf16(float lo, float hi) { unsigned r; asm volatile("v_cvt_pk_bf16_f32 %0, %1, %2" : "=v"(r) : "v"(lo), "v"(hi)); return r; }
__device__ __forceinline__ float clamp448(float v) { return __builtin_amdgcn_fmed3f(v, -448.0f, 448.0f); }
__device__ __forceinline__ unsigned pk4_fp8(float a, float b, float c, float d) {
    int w = 0; w = __builtin_amdgcn_cvt_pk_fp8_f32(clamp448(a), clamp448(b), w, false); w = __builtin_amdgcn_cvt_pk_fp8_f32(clamp448(c), clamp448(d), w, true); return (unsigned)w; }
__device__ __forceinline__ unsigned pk4_fp8_nc(float a, float b, float c, float d) { int w = 0; w = __builtin_amdgcn_cvt_pk_fp8_f32(a, b, w, false); w = __builtin_amdgcn_cvt_pk_fp8_f32(c, d, w, true); return (unsigned)w; }
__device__ __forceinline__ float bf_lo(unsigned w) { return __uint_as_float(w << 16); }
__device__ __forceinline__ float bf_hi(unsigned w) { return __uint_as_float(w & 0xffff0000u); }
template <int CTRL> __device__ __forceinline__ float dppf(float v) { return __int_as_float(__builtin_amdgcn_update_dpp(0, __float_as_int(v), CTRL, 0xf, 0xf, false)); }
template <int CTRL> __device__ __forceinline__ int dppi(int v) { return __builtin_amdgcn_update_dpp(0, v, CTRL, 0xf, 0xf, false); }
__device__ __forceinline__ float xor1f(float v) { return dppf<0xB1>(v); }
__device__ __forceinline__ float xor2f(float v) { return dppf<0x4E>(v); }
__device__ __forceinline__ float xor4f(float v) { return dppf<0x1B>(dppf<0x141>(v)); }
__device__ __forceinline__ float xor8f(float v) { return dppf<0x128>(v); }
__device__ __forceinline__ int xor2i(int v) { return dppi<0x4E>(v); }
__device__ __forceinline__ int xor4i(int v) { return dppi<0x1B>(dppi<0x141>(v)); }
__device__ __forceinline__ int xor8i(int v) { return dppi<0x128>(v); }
__device__ __forceinline__ float xor16f(float v, int lane) { const auto r = __builtin_amdgcn_permlane16_swap(__float_as_uint(v), __float_as_uint(v), false, false); return __uint_as_float((lane & 16) ? r[0] : r[1]); }
__device__ __forceinline__ float xor32f(float v, int lane) { const auto r = __builtin_amdgcn_permlane32_swap(__float_as_uint(v), __float_as_uint(v), false, false); return __uint_as_float((lane & 32) ? r[0] : r[1]); }
__device__ __forceinline__ int xor16i(int v, int lane) { const auto r = __builtin_amdgcn_permlane16_swap((unsigned)v, (unsigned)v, false, false); return (int)((lane & 16) ? r[0] : r[1]); }
__device__ __forceinline__ int xor32i(int v, int lane) { const auto r = __builtin_amdgcn_permlane32_swap((unsigned)v, (unsigned)v, false, false); return (int)((lane & 32) ? r[0] : r[1]); }
__device__ __forceinline__ float sum16f(float v) { const auto r = __builtin_amdgcn_permlane16_swap(__float_as_uint(v), __float_as_uint(v), false, false); return __uint_as_float(r[0]) + __uint_as_float(r[1]); }
__device__ __forceinline__ float sum32f(float v) { const auto r = __builtin_amdgcn_permlane32_swap(__float_as_uint(v), __float_as_uint(v), false, false); return __uint_as_float(r[0]) + __uint_as_float(r[1]); }
__device__ __forceinline__ float wave_sum(float v) {
#pragma unroll
    for (int o = 1; o < 64; o <<= 1) v += __shfl_xor(v, o);
    return v;
}


#define XB_TMO      128
#define XB_XCNT(j)  (256  + 64 * (j))
#define XB_XSUB(j)  (1280 + 64 * (j))
#define XB_XGEN(j)  (2304 + 64 * (j))
#define XB_TOP      3328
#define XB_TOPGEN   3392
#define XCD_BAR_WORDS 3456
#define XB_SPIN_CAP (1u << 22)
__device__ __forceinline__ unsigned xb_ld(unsigned* p)              { return __hip_atomic_load(p, __ATOMIC_RELAXED, __HIP_MEMORY_SCOPE_AGENT); }
__device__ __forceinline__ unsigned xb_add(unsigned* p, unsigned v) { return __hip_atomic_fetch_add(p, v, __ATOMIC_RELAXED, __HIP_MEMORY_SCOPE_AGENT); }
__device__ __forceinline__ unsigned xb_xcc_id() { return (unsigned)__builtin_amdgcn_s_getreg((3 << 11) | 20) & 0xFu; }
#define XB_SPIN(cond, bar) do { unsigned _sp = 0; while (cond) { __builtin_amdgcn_s_sleep(1); \
    if ((++_sp & 255u) == 0u) { if (xb_ld(&(bar)[XB_TMO])) break; if (_sp > XB_SPIN_CAP) { atomicAdd(&(bar)[XB_TMO], 1u); break; } } } } while (0)
struct XcdBarrier { unsigned* bar; unsigned x; volatile LAS unsigned* st; };
__device__ __forceinline__ XcdBarrier xcd_barrier_post(unsigned* bar, volatile LAS unsigned* st) {
    XcdBarrier b; b.bar = bar; b.x = xb_xcc_id(); b.st = st;
    if (threadIdx.x == 0) (void)xb_add(&bar[XB_XCNT(b.x)], 1u);
    return b;
}
__device__ __forceinline__ void xcd_barrier_complete(unsigned* bar, unsigned x, unsigned& nloc, unsigned& nx) {
    const unsigned G = gridDim.x * gridDim.y * gridDim.z;
    unsigned sum, cnt, mine, sp = 0u;
    for (;;) {
        sum = 0u; cnt = 0u; mine = 0u;
#pragma unroll
        for (unsigned j = 0; j < 16; ++j) { const unsigned c = xb_ld(&bar[XB_XCNT(j)]); sum += c; cnt += (c > 0u) ? 1u : 0u; mine = (j == x) ? c : mine; }
        if (sum == G) break;
        __builtin_amdgcn_s_sleep(1);
        if ((++sp & 255u) == 0u) { if (xb_ld(&bar[XB_TMO])) break; if (sp > XB_SPIN_CAP) { atomicAdd(&bar[XB_TMO], 1u); break; } }
    }
    nloc = mine > 0u ? mine : 1u; nx = cnt > 0u ? cnt : 1u;
}
__device__ __forceinline__ void xcd_barrier(const XcdBarrier& b) {
    asm volatile("s_waitcnt vmcnt(0)" ::: "memory");
    __syncthreads();
    if (threadIdx.x == 0) {
        unsigned* bar = b.bar;
        __builtin_amdgcn_s_waitcnt(0);
        unsigned nloc = b.st[0], nx = b.st[1];
        if (nloc == 0u) { xcd_barrier_complete(bar, b.x, nloc, nx); b.st[0] = nloc; b.st[1] = nx; }
        const unsigned old = xb_add(&bar[XB_XSUB(b.x)], 1u);
        const unsigned gen = old / nloc;
        if (old + 1u == (gen + 1u) * nloc) {
            __builtin_amdgcn_fence(__ATOMIC_RELEASE, "agent");
            asm volatile("s_waitcnt vmcnt(0)" ::: "memory");
            const unsigned og = xb_add(&bar[XB_TOP], 1u);
            const unsigned tg = og / nx;
            if (og + 1u == (tg + 1u) * nx) xb_add(&bar[XB_TOPGEN], 1u);
            else XB_SPIN(xb_ld(&bar[XB_TOPGEN]) == tg, bar);
            __builtin_amdgcn_fence(__ATOMIC_ACQUIRE, "agent");
            xb_add(&bar[XB_XGEN(b.x)], 1u);
            asm volatile("s_waitcnt vmcnt(0)" ::: "memory");
        } else {
            XB_SPIN(xb_ld(&bar[XB_XGEN(b.x)]) == gen, bar);
            __builtin_amdgcn_fence(__ATOMIC_ACQUIRE, "agent");
            asm volatile("s_waitcnt vmcnt(0)" ::: "memory");
        }
    }
    __syncthreads();
}

namespace pg8 {
constexpr int BM = 256, BK = 64, HALF = 128, HTB = HALF * BK * 2, STAGE_BYTES = 8 * HTB, NXCD = 8, WGM = 8, K = KDIM;
template <bool FP8> __host__ __device__ __forceinline__ int lds_byte(int r, int col) {
    const int c = col >> 3, low = FP8 ? ((c >> 1) & 1) : (c & 1), mid = FP8 ? (c & 1) : ((c >> 1) & 1);
    return (r >> 3) * 1024 + 16 * (16 * (2 * (c >> 2) + mid) + 2 * (r & 7) + low);
}
template <bool FP8> __host__ __device__ __forceinline__ void stage_rc(int b, int& R, int& C) {
    const int blk = b >> 10, p = (b & 1023) >> 4, r7 = (p & 15) >> 1, low = p & 1, A = p >> 5, B = (p >> 4) & 1;
    const int c = FP8 ? (4 * A + 2 * low + B) : (4 * A + 2 * B + low);
    R = 8 * blk + r7; C = 8 * c;
}
__host__ __device__ __forceinline__ int perm32(int rho) { const int n = rho >> 4, i = rho & 15; return 8 * (i >> 2) + 4 * n + (i & 3); }

struct Unit { int pm, pn, e, r0, nrows; };


typedef int v8i __attribute__((ext_vector_type(8)));
typedef int v4i __attribute__((ext_vector_type(4)));
template <bool FP8, class Epi, class Sched>
__device__ __forceinline__ void gemm_phase(LAS unsigned char* lds, const char* gA, const Sched& S, const Epi& E) {
    int tid_ = threadIdx.x; asm volatile("" : "+v"(tid_));
    const int tid = tid_, wid = __builtin_amdgcn_readfirstlane(tid >> 6), lane = tid & 63, wr = wid >> 2, wc = wid & 3, fr = lane & 15, fq = lane >> 4;
    constexpr int RP = FP8 ? K : 2 * K;
    constexpr int nt = RP / 128;
    int Rs[2], Cs[2]; unsigned voffB[2];
#pragma unroll
    for (int i = 0; i < 2; ++i) { int R, C; stage_rc<FP8>(tid * 16 + i * 8192, R, C);
        const int Rb = Epi::PERM16 ? (64 * (R >> 5) + 16 * ((R & 15) >> 2) + 4 * ((R >> 4) & 1) + (R & 3)) : ((R & ~31) + perm32(R & 31));
        Rs[i] = R; Cs[i] = C; voffB[i] = (unsigned)(Rb * RP + C * 2); }
    const size_t kstep = (size_t)(BK * 2);
    const size_t hstep = (size_t)(Epi::PERM16 ? 8 : HALF) * RP;
    const unsigned ldsw = (unsigned)wid * 1024u;
    const int aoff = lds_byte<FP8>(wr * 64 + fr, FP8 ? fq * 16 : fq * 8), boff = lds_byte<FP8>(wc * 32 + fr, FP8 ? fq * 16 : fq * 8);
    const int scl = 0x7f7f7f7f;
#define PG8_SA(b, h) (((b) * 2 + (h)) * HTB)
#define PG8_SB(b, h) ((4 + (b) * 2 + (h)) * HTB)
#define PG8_STAGE(bufoff, gbase, voff) do { _Pragma("unroll") for (int _i = 0; _i < 2; ++_i) \
        __builtin_amdgcn_global_load_lds((const unsigned*)((const char*)(gbase) + (voff)[_i]), (LAS unsigned*)(lds + (bufoff) + ldsw + _i * 8192), 16, 0, 0); } while (0)
#define PG8_LDA(dst, b, h) do { _Pragma("unroll") for (int m = 0; m < 4; ++m) { \
        if constexpr (FP8) { dst##8[m].lo = *(const LAS v4i*)(lds + PG8_SA(b, h) + aoff + m * 2048); dst##8[m].hi = *(const LAS v4i*)(lds + PG8_SA(b, h) + aoff + m * 2048 + 256); } \
        else { _Pragma("unroll") for (int k = 0; k < 2; ++k) dst[m][k] = *(const LAS bf16x8*)(lds + PG8_SA(b, h) + aoff + m * 2048 + k * 512); } } } while (0)
#define PG8_LDB(dst, b, h) do { _Pragma("unroll") for (int n = 0; n < 2; ++n) { \
        if constexpr (FP8) { dst##8[n].lo = *(const LAS v4i*)(lds + PG8_SB(b, h) + boff + n * 2048); dst##8[n].hi = *(const LAS v4i*)(lds + PG8_SB(b, h) + boff + n * 2048 + 256); } \
        else { _Pragma("unroll") for (int k = 0; k < 2; ++k) dst[n][k] = *(const LAS bf16x8*)(lds + PG8_SB(b, h) + boff + n * 2048 + k * 512); } } } while (0)
#define PG8_ACC(ai, bj, m, n) ((n) == 0 ? acc8[ai][bj][m].lo : acc8[ai][bj][m].hi)
#define PG8_MMA(ai, bj, At, Bt) do { __builtin_amdgcn_s_setprio(1); _Pragma("unroll") for (int m = 0; m < 4; ++m) { \
        if constexpr (FP8) { f32x4 lo_ = acc8[ai][bj][m].lo, hi_ = acc8[ai][bj][m].hi; \
                             if (m == 0) asm volatile("s_nop 1\n\tv_mfma_scale_f32_16x16x128_f8f6f4 %0, %1, %2, %0, %3, %3 op_sel_hi:[0,0,0]" : "+v"(lo_) : "v"(Bt##8[0]), "v"(At##8[m]), "v"(scl)); \
                             else        asm volatile("v_mfma_scale_f32_16x16x128_f8f6f4 %0, %1, %2, %0, %3, %3 op_sel_hi:[0,0,0]" : "+v"(lo_) : "v"(Bt##8[0]), "v"(At##8[m]), "v"(scl)); \
                             asm volatile("v_mfma_scale_f32_16x16x128_f8f6f4 %0, %1, %2, %0, %3, %3 op_sel_hi:[0,0,0]" : "+v"(hi_) : "v"(Bt##8[1]), "v"(At##8[m]), "v"(scl)); \
                             acc8[ai][bj][m].lo = lo_; acc8[ai][bj][m].hi = hi_; } \
        else { _Pragma("unroll") for (int k = 0; k < 2; ++k) { acc8[ai][bj][m].lo = __builtin_amdgcn_mfma_f32_16x16x32_bf16(Bt[0][k], At[m][k], acc8[ai][bj][m].lo, 0, 0, 0); \
                                                                acc8[ai][bj][m].hi = __builtin_amdgcn_mfma_f32_16x16x32_bf16(Bt[1][k], At[m][k], acc8[ai][bj][m].hi, 0, 0, 0); } } } \
        __builtin_amdgcn_s_setprio(0); } while (0)
#define PG8_ZERO(ai) do { _Pragma("unroll") for (int b_ = 0; b_ < 2; ++b_) { _Pragma("unroll") for (int m_ = 0; m_ < 4; ++m_) acc8[ai][b_][m_] = (f32x8){0.f, 0.f, 0.f, 0.f, 0.f, 0.f, 0.f, 0.f}; } } while (0)
#define PG8_WAIT_V(n) asm volatile("s_waitcnt vmcnt(" #n ")" ::: "memory")
#define PG8_WAIT_L(n) asm volatile("s_waitcnt lgkmcnt(" #n ")" ::: "memory")
#define PG8_BAR __builtin_amdgcn_s_barrier()
#define PG8_SCHED __builtin_amdgcn_sched_barrier(0)
    Unit cur, nxt; int ui = 0;
    if (!S.next(0, cur)) return;
    typedef float f32x8 __attribute__((ext_vector_type(8)));
    f32x8 acc8[2][2][4];
#pragma unroll
    for (int a = 0; a < 2; ++a)
#pragma unroll
        for (int b = 0; b < 2; ++b)
#pragma unroll
            for (int m = 0; m < 4; ++m) acc8[a][b][m] = (f32x8){0.f, 0.f, 0.f, 0.f, 0.f, 0.f, 0.f, 0.f};
    bf16x8 At[4][2], B0[2][2], B1[2][2]; v8i At8[4], B08[2], B18[2];
    unsigned aoc[2][2], aon[2][2];
#pragma unroll
    for (int h = 0; h < 2; ++h)
#pragma unroll
        for (int i = 0; i < 2; ++i) aoc[h][i] = S.arow(cur, h * HALF + Rs[i]) + (unsigned)Cs[i] * 2u;
    const char* cB = S.bbase(cur);
    PG8_STAGE(PG8_SB(0, 0), cB, voffB); PG8_STAGE(PG8_SB(0, 1), cB + hstep, voffB); PG8_STAGE(PG8_SA(0, 0), gA, aoc[0]); PG8_STAGE(PG8_SA(0, 1), gA, aoc[1]);
    if (wr == 1) PG8_BAR;
    PG8_WAIT_V(2); PG8_BAR;
    PG8_STAGE(PG8_SB(1, 0), cB + kstep, voffB); PG8_STAGE(PG8_SA(1, 0), gA + kstep, aoc[0]); PG8_STAGE(PG8_SB(1, 1), cB + hstep + kstep, voffB);
    PG8_WAIT_V(6); PG8_BAR;
    for (;;) {
        const bool has_next = S.next(ui + 1, nxt);
        const char* nB = has_next ? S.bbase(nxt) : cB;
#pragma unroll
        for (int h = 0; h < 2; ++h)
#pragma unroll
            for (int i = 0; i < 2; ++i) aon[h][i] = has_next ? (S.arow(nxt, h * HALF + Rs[i]) + (unsigned)Cs[i] * 2u) : aoc[h][i];
#pragma unroll 1
        for (int t = 0; t < nt; t += 2) {
            const bool last = (t == nt - 2);
            if constexpr (Epi::PREDMA) { if (t == nt - 4) E.pre_dma(cur, tid, wid, lds + EPM_OFF); }
            const char* a1 = gA + (size_t)(t + 1) * kstep;
            const char* a2 = last ? gA : gA + (size_t)(t + 2) * kstep; const char* b2 = last ? nB : cB + (size_t)(t + 2) * kstep;
            const char* a3 = a2 + kstep; const char* b3 = b2 + kstep;
            unsigned o2[2][2];
            if (last) {
                asm volatile("" : "+v"(aon[0][0]), "+v"(aon[0][1]), "+v"(aon[1][0]), "+v"(aon[1][1]));
#pragma unroll
                for (int h = 0; h < 2; ++h)
#pragma unroll
                    for (int i = 0; i < 2; ++i) o2[h][i] = aon[h][i];
            } else {
#pragma unroll
                for (int h = 0; h < 2; ++h)
#pragma unroll
                    for (int i = 0; i < 2; ++i) o2[h][i] = aoc[h][i];
            }
            const bool zero_now = (t == 0) && (ui > 0);
            PG8_LDB(B0, 0, 0); PG8_LDB(B1, 0, 1); PG8_SCHED; PG8_LDA(At, 0, 0); PG8_STAGE(PG8_SA(1, 1), a1, aoc[1]);
            if (zero_now) { PG8_ZERO(0); }
            PG8_WAIT_V(8); PG8_WAIT_L(0); PG8_BAR; PG8_MMA(0, 0, At, B0); PG8_MMA(0, 1, At, B1); PG8_BAR; PG8_SCHED;
            PG8_LDA(At, 0, 1); PG8_STAGE(PG8_SB(0, 0), b2, voffB); PG8_STAGE(PG8_SB(0, 1), b2 + hstep, voffB); PG8_STAGE(PG8_SA(0, 0), a2, o2[0]);
            if (zero_now) { PG8_ZERO(1); }
            PG8_WAIT_V(8); PG8_WAIT_L(0); PG8_BAR; PG8_MMA(1, 0, At, B0); PG8_MMA(1, 1, At, B1); PG8_BAR; PG8_SCHED;
            PG8_LDB(B0, 1, 0); PG8_LDB(B1, 1, 1); PG8_SCHED; PG8_LDA(At, 1, 0); PG8_STAGE(PG8_SA(0, 1), a2, o2[1]);
            PG8_WAIT_V(8); PG8_WAIT_L(0); PG8_BAR; PG8_MMA(0, 0, At, B0); PG8_MMA(0, 1, At, B1); PG8_BAR; PG8_SCHED;
            PG8_LDA(At, 1, 1); PG8_STAGE(PG8_SB(1, 0), b3, voffB); PG8_STAGE(PG8_SB(1, 1), b3 + hstep, voffB); PG8_STAGE(PG8_SA(1, 0), a3, o2[0]);
            PG8_WAIT_V(8); PG8_WAIT_L(0); PG8_BAR; PG8_MMA(1, 0, At, B0); PG8_MMA(1, 1, At, B1); PG8_BAR; PG8_SCHED;
        }
        if constexpr (FP8) asm volatile("s_nop 15\n\ts_nop 7" ::: "memory");
        if (wr == 0) PG8_BAR;
        { int fr_ = fr, fq_ = fq; asm volatile("" : "+v"(fr_), "+v"(fq_));
          f32x4 acc[2][2][4][2];
#pragma unroll
          for (int a = 0; a < 2; ++a)
#pragma unroll
              for (int b = 0; b < 2; ++b)
#pragma unroll
                  for (int m = 0; m < 4; ++m) { acc[a][b][m][0] = acc8[a][b][m].lo; acc[a][b][m][1] = acc8[a][b][m].hi; }
          E(acc, cur, wr, wc, fr_, fq_); }
        if (!has_next) break;
        cur = nxt; cB = nB; ++ui;
#pragma unroll
        for (int h = 0; h < 2; ++h)
#pragma unroll
            for (int i = 0; i < 2; ++i) aoc[h][i] = aon[h][i];
        if (wr == 1) PG8_BAR;
    }
    PG8_WAIT_V(0);
    PG8_BAR;
#undef PG8_SA
#undef PG8_SB
#undef PG8_STAGE
#undef PG8_LDA
#undef PG8_LDB
#undef PG8_MMA
#undef PG8_ZERO
#undef PG8_WAIT_V
#undef PG8_WAIT_L
#undef PG8_BAR
#undef PG8_SCHED
}

struct DenseOrder {
    const char* Bt; int nM, nN, nwg, G, c;
    __device__ void init(const void* Bt_, int M, int N, int G_, int c_) { Bt = (const char*)Bt_; nM = M / BM; nN = N / BM; nwg = nM * nN; G = G_; c = c_; }
    __device__ __forceinline__ bool next(int i, Unit& u) const {
        const long L = (long)i * G + c; if (L >= nwg) return false;
        int wgid = (int)L; { const int q = nwg / NXCD, r = nwg % NXCD, xcd = wgid % NXCD, off = wgid / NXCD; wgid = (xcd < r ? xcd * (q + 1) : r * (q + 1) + (xcd - r) * q) + off; }
        const int nig = WGM * nN, gid = wgid / nig, fm = gid * WGM, gsz = (nM - fm) < WGM ? (nM - fm) : WGM;
        u.pm = fm + ((wgid % nig) % gsz); u.pn = (wgid % nig) / gsz; u.e = 0; u.r0 = 0; u.nrows = BM; return true;
    }
    __device__ __forceinline__ const char* bbase(const Unit& u) const { return Bt + (size_t)u.pn * BM * K * 2; }
    __device__ __forceinline__ unsigned arow(const Unit& u, int r) const { return (unsigned)(u.pm * BM + r) * (unsigned)(K * 2); }
};
}

struct Frame {
    LAS unsigned char* lds; LAS int* MS;
    int tid, lane, wave, vcu, G;
    unsigned char* ws; float* out;
    const float* in[22];
};
enum { I_X = 0, I_N1G, I_WIN, I_AQG, I_AKG, I_LQ1, I_LK1, I_LQ2, I_LK2, I_SUBG, I_BQG, I_BKG, I_WOUT, I_N2G, I_RW, I_RB, I_WG, I_BG, I_WU, I_BU, I_WDN, I_BD };

__device__ __forceinline__ size_t moe_idx(const LAS int* MS, int e, int m) {
    const LAS int* cum = MS + MS_CUM + 4 * e; const LAS int* adj = MS + MS_ADJ + 4 * e;
    const int c1 = cum[1], c2 = cum[2], c3 = cum[3];
    int a = adj[0]; a = (m >= c1) ? adj[1] : a; a = (m >= c2) ? adj[2] : a; a = (m >= c3) ? adj[3] : a;
    return (size_t)(unsigned)(m + a);
}
__device__ __forceinline__ int moe_tok(const LAS int* MS, const unsigned char* ws, int e, int m) { return ((const int*)(ws + WS_ENT))[moe_idx(MS, e, m)]; }
struct MoeUpOrder {
    const LAS int* MS; const unsigned char* ws; const char* Bt; int G, vcu;
    __device__ __forceinline__ bool next(int i, pg8::Unit& u) const {
        const LAS int* tp = MS + MS_TILE; const int total = tp[NEXP] * 8;
        const long L = (long)i * G + vcu; if (L >= total) return false;
        const int rt = (int)(L >> 3); u.pn = (int)(L & 7);
        const int e = MS[MS_TEXP + rt];
        u.e = e; u.pm = rt - tp[e]; u.r0 = u.pm * 256; const int ne = MS[MS_NE + e]; u.nrows = (ne - u.r0) < 256 ? (ne - u.r0) : 256; return true;
    }
    __device__ __forceinline__ const char* bbase(const pg8::Unit& u) const { return Bt + ((size_t)u.e * 2048 + (size_t)u.pn * 256) * KDIM; }
    __device__ __forceinline__ unsigned arow(const pg8::Unit& u, int r) const { const int rr = r < u.nrows ? r : u.nrows - 1; return (unsigned)moe_tok(MS, ws, u.e, u.r0 + rr) * (unsigned)KDIM; }
};
struct MoeDownOrder {
    const LAS int* MS; const char* Bt; int G, vcu;
    __device__ __forceinline__ bool next(int i, pg8::Unit& u) const {
        const LAS int* tp = MS + MS_TILE; const int total = tp[NEXP] * 4;
        const long L = (long)i * G + vcu; if (L >= total) return false;
        const int rt = (int)(L >> 2); u.pn = (int)(L & 3);
        const int e = MS[MS_TEXP + rt];
        u.e = e; u.pm = rt - tp[e]; u.r0 = u.pm * 256; const int ne = MS[MS_NE + e]; u.nrows = (ne - u.r0) < 256 ? (ne - u.r0) : 256; return true;
    }
    __device__ __forceinline__ const char* bbase(const pg8::Unit& u) const { return Bt + ((size_t)u.e * 1024 + (size_t)u.pn * 256) * KDIM; }
    __device__ __forceinline__ unsigned arow(const pg8::Unit& u, int r) const {
        const int rr = r < u.nrows ? r : u.nrows - 1;
        return (unsigned)(MS[MS_BASE + u.e] + u.r0 + rr) * (unsigned)KDIM;
    }
};

using pg8::Unit;
struct EpiInProj {
    static constexpr bool PERM16 = false; static constexpr bool PREDMA = false;
    unsigned char* ws; const LAS float* tabs;
    __device__ __forceinline__ void operator()(const f32x4 (&acc)[2][2][4][2], const Unit& u, int wr, int wc, int fr, int fq) const {
        int type, head; const int pn = u.pn;
        if (pn < 2) { type = 0; head = pn * 4 + wc; } else if (pn < 4) { type = 1; head = (pn - 2) * 4 + wc; } else if (pn < 6) { type = 2; head = (pn - 4) * 4 + wc; }
        else if (pn < 8) { type = 3; head = (pn - 6) * 4 + wc; } else if (wc < 2) { type = 4; head = wc; } else { type = 5; head = wc - 2; }
        bf16_t* dst = (bf16_t*)(ws + WS_QA + (size_t)(type <= 3 ? 32 * type : 128 + 8 * (type - 4)) * MiB);
        const int nheads = type <= 3 ? 8 : 2;
        const bool norm = (type != 2 && type != 5);
        const bool axial = type >= 3;
        const LAS float* gn = tabs + 64 * (type == 0 ? 0 : type == 1 ? 1 : type == 3 ? 2 : 3);
        const float scale = (type == 0 || type == 3) ? C2 : 1.0f;
        const int row0 = u.pm * 256 + wr * 64 + fr; const int b = row0 >> 12;
        dst += ((size_t)(b * nheads + head) * SEQ) * 64 + 8 * fq;
        f32x4 g0[2], g1[2], fr2[2];
        if (norm) {
            const LAS float* fqt = tabs + 256 + (axial ? 32 : 0);
#pragma unroll
            for (int n = 0; n < 2; ++n) { g0[n] = *(const LAS f32x4*)(gn + 8 * fq + 4 * n); g1[n] = *(const LAS f32x4*)(gn + 32 + 8 * fq + 4 * n); fr2[n] = *(const LAS f32x4*)(fqt + 8 * fq + 4 * n); }
        }
#pragma unroll
        for (int ai = 0; ai < 2; ++ai)
#pragma unroll
            for (int m = 0; m < 4; ++m) {
                const int s = (row0 + ai * 128 + m * 16) & (SEQ - 1);
                f32x4 v0[2], v1[2];
#pragma unroll
                for (int n = 0; n < 2; ++n) { v0[n] = acc[ai][0][m][n]; v1[n] = acc[ai][1][m][n]; }
                if (norm) {
                    float ss = 0.f;
#pragma unroll
                    for (int n = 0; n < 2; ++n)
#pragma unroll
                        for (int j = 0; j < 4; ++j) ss += v0[n][j] * v0[n][j] + v1[n][j] * v1[n][j];
                    ss += __shfl_xor(ss, 16); ss += __shfl_xor(ss, 32);
                    const float rstd = __builtin_amdgcn_rsqf(ss * (1.0f / 64.0f) + EPS);
                    const float pos = axial ? (float)((fq < 2) ? (s >> 6) : (s & 63)) : (float)s;
#pragma unroll
                    for (int n = 0; n < 2; ++n) {
                        f32x4 c, sn;
#pragma unroll
                        for (int j = 0; j < 4; ++j) { const float rev = __builtin_amdgcn_fractf(pos * fr2[n][j]); c[j] = __builtin_amdgcn_cosf(rev); sn[j] = __builtin_amdgcn_sinf(rev); }
                        const f32x4 y0 = v0[n] * rstd * g0[n], y1 = v1[n] * rstd * g1[n];
                        v0[n] = (y0 * c - y1 * sn) * scale; v1[n] = (y1 * c + y0 * sn) * scale;
                    }
                }
                u32x4 w0, w1;
                w0.x = cvt_pk_bf16(v0[0][0], v0[0][1]); w0.y = cvt_pk_bf16(v0[0][2], v0[0][3]); w0.z = cvt_pk_bf16(v0[1][0], v0[1][1]); w0.w = cvt_pk_bf16(v0[1][2], v0[1][3]);
                w1.x = cvt_pk_bf16(v1[0][0], v1[0][1]); w1.y = cvt_pk_bf16(v1[0][2], v1[0][3]); w1.z = cvt_pk_bf16(v1[1][0], v1[1][1]); w1.w = cvt_pk_bf16(v1[1][2], v1[1][3]);
                bf16_t* p = dst + (size_t)s * 64;
                *(u32x4*)p = w0; *(u32x4*)(p + 32) = w1;
            }
    }
};
struct EpiOutProj {
    static constexpr bool PERM16 = true; static constexpr bool PREDMA = false;
    const bf16_t* xn; const float* sig; bf16_t* x1b; unsigned char* x18;
    __device__ __forceinline__ void operator()(const f32x4 (&acc)[2][2][4][2], const Unit& u, int wr, int wc, int fr, int fq) const {
        const int row0 = u.pm * 256 + wr * 64 + fr, col0 = u.pn * 256 + wc * 64 + 16 * fq;
#pragma unroll
        for (int ai = 0; ai < 2; ++ai) {
            u32x4 xa[4][2]; float sg[4];
#pragma unroll
            for (int m = 0; m < 4; ++m) { const size_t off = (size_t)(row0 + ai * 128 + m * 16) * DMODEL + col0;
                xa[m][0] = __builtin_nontemporal_load((const u32x4*)(xn + off)); xa[m][1] = __builtin_nontemporal_load((const u32x4*)(xn + off + 8)); sg[m] = sig[row0 + ai * 128 + m * 16]; }
#pragma unroll
            for (int m = 0; m < 4; ++m) {
                const size_t off = (size_t)(row0 + ai * 128 + m * 16) * DMODEL + col0;
                f32x4 v[4];
#pragma unroll
                for (int bj = 0; bj < 2; ++bj)
#pragma unroll
                    for (int n = 0; n < 2; ++n) { const unsigned w0 = xa[m][bj][2 * n], w1 = xa[m][bj][2 * n + 1]; f32x4 xv; xv[0] = bf_lo(w0); xv[1] = bf_hi(w0); xv[2] = bf_lo(w1); xv[3] = bf_hi(w1);
                        v[2 * bj + n] = xv * sg[m] + acc[ai][bj][m][n]; }
                u32x4 wb0, wb1, w8;
                wb0.x = cvt_pk_bf16(v[0][0], v[0][1]); wb0.y = cvt_pk_bf16(v[0][2], v[0][3]); wb0.z = cvt_pk_bf16(v[1][0], v[1][1]); wb0.w = cvt_pk_bf16(v[1][2], v[1][3]);
                wb1.x = cvt_pk_bf16(v[2][0], v[2][1]); wb1.y = cvt_pk_bf16(v[2][2], v[2][3]); wb1.z = cvt_pk_bf16(v[3][0], v[3][1]); wb1.w = cvt_pk_bf16(v[3][2], v[3][3]);
                w8.x = pk4_fp8(v[0][0], v[0][1], v[0][2], v[0][3]); w8.y = pk4_fp8(v[1][0], v[1][1], v[1][2], v[1][3]); w8.z = pk4_fp8(v[2][0], v[2][1], v[2][2], v[2][3]); w8.w = pk4_fp8(v[3][0], v[3][1], v[3][2], v[3][3]);
                *(u32x4*)(x1b + off) = wb0; *(u32x4*)(x1b + off + 8) = wb1;
                *(u32x4*)(x18 + off) = w8;
            }
            asm volatile("" ::: "memory");
        }
    }
};
constexpr float SWC = 2.4554669595930156f;
struct EpiSwiglu {
    static constexpr bool PERM16 = false; static constexpr bool PREDMA = true;
    const LAS int* MS; const unsigned char* ws; const float *bg, *bu; unsigned char* mid;
    __device__ __forceinline__ void pre_dma(const Unit& u, int tid, int wid, LAS unsigned char* epm) const {
        const float* src;
        if (wid < 4) { const float* ent_rstd = (const float*)(ws + WS_ENT + (size_t)2 * NBIN * CAP * 4); const int rr = tid < u.nrows ? tid : u.nrows - 1; src = ent_rstd + moe_idx(MS, u.e, u.r0 + rr); }
        else { const int c = tid & 127; src = (wid < 6 ? bg : bu) + u.e * DEXP + u.pn * 128 + c; }
        __builtin_amdgcn_global_load_lds((const unsigned*)src, (LAS unsigned*)(epm + wid * 256), 4, 0, 0);
    }
    __device__ __forceinline__ void operator()(const f32x4 (&acc)[2][2][4][2], const Unit& u, int wr, int wc, int fr, int fq) const {
        const int col0 = u.pn * 128 + wc * 32 + 8 * fq;
        const LAS float* epm = (const LAS float*)((const LAS unsigned char*)MS + (EPM_OFF - MISC_OFF));
        float rs[8];
#pragma unroll
        for (int q = 0; q < 8; ++q) { const int r = (q >> 2) * 128 + wr * 64 + (q & 3) * 16 + fr; rs[q] = epm[r] * (1.0f / 64.0f); }
        f32x4 vbg[2], vbu[2];
#pragma unroll
        for (int n = 0; n < 2; ++n) { vbg[n] = *(const LAS f32x4*)(epm + 256 + wc * 32 + 8 * fq + 4 * n); vbu[n] = *(const LAS f32x4*)(epm + 384 + wc * 32 + 8 * fq + 4 * n); }
        const int mbase = MS[MS_BASE + u.e];
        auto row8 = [&](int ai, int m) -> u32x2 {
            const float rsq = rs[ai * 4 + m], rsqc = rsq * SWC, rsqi = rsq * (1.0f / SWC); unsigned wq[2];
#pragma unroll
            for (int n = 0; n < 2; ++n) {
                f32x2 o2[2];
#pragma unroll
                for (int h = 0; h < 2; ++h) {
                    const f32x2 ag = (f32x2){acc[ai][0][m][n][2 * h], acc[ai][0][m][n][2 * h + 1]}, au = (f32x2){acc[ai][1][m][n][2 * h], acc[ai][1][m][n][2 * h + 1]};
                    const f32x2 bgv = (f32x2){vbg[n][2 * h], vbg[n][2 * h + 1]}, buv = (f32x2){vbu[n][2 * h], vbu[n][2 * h + 1]};
                    f32x2 gc = ag * rsqc + bgv * SWC, uc = au * rsqi + (buv + 1.0f) * (1.0f / SWC);
                    gc.x = fminf(gc.x, 7.0f * SWC); gc.y = fminf(gc.y, 7.0f * SWC);
                    uc.x = __builtin_amdgcn_fmed3f(uc.x, -6.0f / SWC, 8.0f / SWC); uc.y = __builtin_amdgcn_fmed3f(uc.y, -6.0f / SWC, 8.0f / SWC);
                    f32x2 t; t.x = __builtin_amdgcn_exp2f(-gc.x); t.y = __builtin_amdgcn_exp2f(-gc.y);
                    t = t + 1.0f; f32x2 sg; sg.x = __builtin_amdgcn_rcpf(t.x); sg.y = __builtin_amdgcn_rcpf(t.y);
                    o2[h] = uc * (gc * sg);
                }
                int w_ = 0; w_ = __builtin_amdgcn_cvt_pk_fp8_f32(o2[0].x, o2[0].y, w_, false); w_ = __builtin_amdgcn_cvt_pk_fp8_f32(o2[1].x, o2[1].y, w_, true); wq[n] = (unsigned)w_;
            }
            u32x2 w; w.x = wq[0]; w.y = wq[1]; return w; };
        const int colw = u.pn * 128 + wc * 32 + 16 * (fq >> 1);
#pragma unroll
        for (int ai = 0; ai < 2; ++ai)
#pragma unroll
            for (int mp = 0; mp < 2; ++mp) {
                const u32x2 wa = row8(ai, 2 * mp), wb = row8(ai, 2 * mp + 1);
                const auto sx = __builtin_amdgcn_permlane16_swap(wa.x, wb.x, false, false), sy = __builtin_amdgcn_permlane16_swap(wa.y, wb.y, false, false);
                u32x4 w; w.x = sx[0]; w.y = sy[0]; w.z = sx[1]; w.w = sy[1];
                const int r = ai * 128 + wr * 64 + (2 * mp + (fq & 1)) * 16 + fr;
                if (r < u.nrows) *(u32x4*)(mid + (size_t)(mbase + u.r0 + r) * DEXP + colw) = w;
            }
    }
};
struct EpiDownY {
    static constexpr bool PERM16 = true; static constexpr bool PREDMA = true;
    const LAS int* MS; const unsigned char* ws; const float* bd; unsigned char* Y;
    __device__ __forceinline__ void pre_dma(const Unit& u, int tid, int wid, LAS unsigned char* epm) const {
        const float* src;
        if (wid < 4) { const float* ent_gate = (const float*)(ws + WS_ENT + (size_t)NBIN * CAP * 4); const int rr = tid < u.nrows ? tid : u.nrows - 1; src = ent_gate + moe_idx(MS, u.e, u.r0 + rr); }
        else { src = bd + u.e * DMODEL + u.pn * 256 + (tid & 255); }
        __builtin_amdgcn_global_load_lds((const unsigned*)src, (LAS unsigned*)(epm + wid * 256), 4, 0, 0);
    }
    __device__ __forceinline__ void operator()(const f32x4 (&acc)[2][2][4][2], const Unit& u, int wr, int wc, int fr, int fq) const {
        const int col0 = u.pn * 256 + wc * 64 + 16 * fq;
        const LAS float* epm = (const LAS float*)((const LAS unsigned char*)MS + (EPM_OFF - MISC_OFF));
        float gate[8];
#pragma unroll
        for (int q = 0; q < 8; ++q) { const int r = (q >> 2) * 128 + wr * 64 + (q & 3) * 16 + fr; gate[q] = epm[r] * (1.0f / 64.0f); }
        f32x4 vb[2][2];
#pragma unroll
        for (int bj = 0; bj < 2; ++bj)
#pragma unroll
            for (int n = 0; n < 2; ++n) vb[bj][n] = *(const LAS f32x4*)(epm + 256 + wc * 64 + 16 * fq + 8 * bj + 4 * n) * 64.0f;
        const int mbase = MS[MS_BASE + u.e] + u.r0;
#pragma unroll
        for (int ai = 0; ai < 2; ++ai)
#pragma unroll
            for (int m = 0; m < 4; ++m) {
                const int r = ai * 128 + wr * 64 + m * 16 + fr; const float gt = gate[ai * 4 + m];
                u32x4 w;
                unsigned wq[4];
#pragma unroll
                for (int bj = 0; bj < 2; ++bj)
#pragma unroll
                    for (int n = 0; n < 2; ++n) { const f32x4 a = (acc[ai][bj][m][n] + vb[bj][n]) * gt;
                        int w0 = 0; w0 = __builtin_amdgcn_cvt_pk_fp8_f32(a[0], a[1], w0, false); w0 = __builtin_amdgcn_cvt_pk_fp8_f32(a[2], a[3], w0, true); wq[2 * bj + n] = (unsigned)w0; }
                w.x = wq[0]; w.y = wq[1]; w.z = wq[2]; w.w = wq[3];
                if (r < u.nrows) *(u32x4*)(Y + (size_t)(mbase + r) * DMODEL + col0) = w;
            }
    }
};

struct EpiNull {
    static constexpr bool PERM16 = false; static constexpr bool PREDMA = false;
    __device__ __forceinline__ void operator()(const f32x4 (&acc)[2][2][4][2], const Unit& u, int wr, int wc, int fr, int fq) const {
#pragma unroll
        for (int ai = 0; ai < 2; ++ai)
#pragma unroll
            for (int bj = 0; bj < 2; ++bj)
#pragma unroll
                for (int m = 0; m < 4; ++m) asm volatile("" :: "v"(acc[ai][bj][m][0]), "v"(acc[ai][bj][m][1]));
    }
};
namespace attn_body {
using bf16 = __hip_bfloat16;
using s16x4 = __attribute__((ext_vector_type(4))) short;
using f32x16 = __attribute__((ext_vector_type(16))) float;
constexpr int D = 64, NW = 8, QBLK = 32, QB = QBLK * NW, KVBLK = 64, NT = SEQ / KVBLK;
__device__ __forceinline__ int crow(int r, int hi) { return (r & 3) + 8 * (r >> 2) + 4 * hi; }
#define SBAR() __builtin_amdgcn_sched_barrier(0)
constexpr int NSLOT = 3, SLOTB = 8192;
constexpr int LDS_K = 0, LDS_V = NSLOT * SLOTB, LDS_WS = 2 * NSLOT * SLOTB, LDS_OST = LDS_WS + NW * 64 * 4, ATTN_LDS_BYTES = LDS_OST + NW * 4096;
__device__ __forceinline__ void glds16(const void* gsrc, unsigned lds_dst) { unsigned keep;
  asm volatile("s_mov_b32 %0, m0\n\ts_mov_b32 m0, %2\n\ts_nop 0\n\tglobal_load_lds_dwordx4 %1, off\n\ts_mov_b32 m0, %0" : "=&s"(keep) : "v"(gsrc), "s"(lds_dst) : "memory"); }
typedef float f32x2_t __attribute__((ext_vector_type(2))); typedef __bf16 bf16x2_t __attribute__((ext_vector_type(2)));
__device__ __forceinline__ unsigned cvtpk_s(float lo, float hi) { f32x2_t v = {lo, hi}; bf16x2_t b = __builtin_convertvector(v, bf16x2_t); return __builtin_bit_cast(unsigned, b); }
#define WAIT_BAR(N) asm volatile("s_waitcnt vmcnt(" #N ") lgkmcnt(0)\n\ts_barrier" ::: "memory")

__device__ __forceinline__ void qkt(f32x16& p0, f32x16& p1, const char* Kslot, const bf16x8* qr, const f32x16& negm, int r32, int hi) {
  const char* kb = Kslot + hi * 1024 + r32 * 16;
  #pragma unroll
  for (int d0 = 0; d0 < 4; ++d0) {
    const bf16x8 b0 = *reinterpret_cast<const bf16x8*>(kb + d0 * 2048);
    const bf16x8 b1 = *reinterpret_cast<const bf16x8*>(kb + d0 * 2048 + 512);
    if (d0 == 0) { p0 = __builtin_amdgcn_mfma_f32_32x32x16_bf16(b0, qr[0], negm, 0, 0, 0); p1 = __builtin_amdgcn_mfma_f32_32x32x16_bf16(b1, qr[0], negm, 0, 0, 0); }
    else { p0 = __builtin_amdgcn_mfma_f32_32x32x16_bf16(b0, qr[d0], p0, 0, 0, 0); p1 = __builtin_amdgcn_mfma_f32_32x32x16_bf16(b1, qr[d0], p1, 0, 0, 0); } }
}
typedef __attribute__((address_space(3))) const char* lds_cptr;
typedef short v4i16_t __attribute__((ext_vector_type(4)));
__device__ __forceinline__ void kload8(bf16x8* kf, lds_cptr kp) {
  kf[0] = *(const LAS bf16x8*)(kp);        kf[1] = *(const LAS bf16x8*)(kp + 512);
  kf[2] = *(const LAS bf16x8*)(kp + 2048); kf[3] = *(const LAS bf16x8*)(kp + 2560);
  kf[4] = *(const LAS bf16x8*)(kp + 4096); kf[5] = *(const LAS bf16x8*)(kp + 4608);
  kf[6] = *(const LAS bf16x8*)(kp + 6144); kf[7] = *(const LAS bf16x8*)(kp + 6656);
}
__device__ __forceinline__ void kload2(bf16x8* kf, lds_cptr kp, int j) { kf[2 * j] = *(const LAS bf16x8*)(kp + j * 2048); kf[2 * j + 1] = *(const LAS bf16x8*)(kp + j * 2048 + 512); }
__device__ __forceinline__ s16x4 vtr(lds_cptr p) { return __builtin_bit_cast(s16x4, __builtin_amdgcn_ds_read_tr16_b64_v4i16((LAS v4i16_t*)p)); }
__device__ __forceinline__ void pv(f32x16* o, int vb, bf16x8 pa0, bf16x8 pa1, bf16x8 pa2, bf16x8 pa3) {
  #pragma unroll
  for (int d0 = 0; d0 < 2; ++d0) { s16x4 lo[4], hi[4];
    #pragma unroll
    for (int ks = 0; ks < 4; ++ks) {
      asm volatile("ds_read_b64_tr_b16 %0,%1 offset:%c2" : "=&v"(lo[ks]) : "v"(vb), "i"(d0 * 4096 + ks * 1024) : "memory");
      asm volatile("ds_read_b64_tr_b16 %0,%1 offset:%c2" : "=&v"(hi[ks]) : "v"(vb), "i"(d0 * 4096 + ks * 1024 + 512) : "memory"); }
    asm volatile("s_waitcnt lgkmcnt(0)" ::: "memory"); SBAR();
    #define PK(k) (bf16x8){lo[k][0], lo[k][1], lo[k][2], lo[k][3], hi[k][0], hi[k][1], hi[k][2], hi[k][3]}
    o[d0] = __builtin_amdgcn_mfma_f32_32x32x16_bf16(pa0, PK(0), o[d0], 0, 0, 0);
    o[d0] = __builtin_amdgcn_mfma_f32_32x32x16_bf16(pa1, PK(1), o[d0], 0, 0, 0);
    o[d0] = __builtin_amdgcn_mfma_f32_32x32x16_bf16(pa2, PK(2), o[d0], 0, 0, 0);
    o[d0] = __builtin_amdgcn_mfma_f32_32x32x16_bf16(pa3, PK(3), o[d0], 0, 0, 0);
    #undef PK
  }
}

template <int THRL> __device__ __forceinline__ void attn_unit(const bf16* Qrows, const bf16* __restrict__ Kh, const bf16* __restrict__ Vh, bf16* Orows, int opitch, char* shm,
                                                              const int primed, const bf16* Qnext, const bf16* Knext, bf16x8 (&qc)[4]) {
  int tid_ = threadIdx.x; asm volatile("" : "+v"(tid_));
  const int tid = tid_, lane = tid & 63, r32 = lane & 31, hi = lane >> 5; const int wid = __builtin_amdgcn_readfirstlane(tid >> 6);
  const bf16* Qw = Qrows + (long)(wid * QBLK) * D;
  const unsigned lds0 = (unsigned)(uintptr_t)shm;
  float* wsf = (float*)(shm + LDS_WS) + wid * 64;
  const bf16* ksrc = Kh + (long)lane * D + wid * 8;
  const bf16* vsrc = Vh + (long)(16 * (wid & 3) + (lane >> 2)) * D + (wid >> 2) * 32 + (lane & 3) * 8;
  const unsigned kdst = lds0 + LDS_K + wid * 1024, vdst = lds0 + LDS_V + wid * 1024;
  #define DMA_K(t, slot) glds16(ksrc + (long)(t) * KVBLK * D, (unsigned)__builtin_amdgcn_readfirstlane(kdst + (slot)))
  #define DMA_V(t, slot) glds16(vsrc + (long)(t) * KVBLK * D, (unsigned)__builtin_amdgcn_readfirstlane(vdst + (slot)))
  const int vb0 = (int)(lds0 + LDS_V) + ((lane >> 4) & 1) * 32 + (lane & 3) * 8 + (4 * hi + ((lane & 15) >> 2)) * 64;
  const char* Kbase = shm + LDS_K; bf16x8 kf[8];
  const lds_cptr shm3 = (lds_cptr)shm; const lds_cptr kp0 = shm3 + LDS_K + hi * 1024 + r32 * 16; const lds_cptr vp0 = shm3 + LDS_V + ((lane >> 4) & 1) * 32 + (lane & 3) * 8 + (4 * hi + ((lane & 15) >> 2)) * 64;
  bf16x8 qr[4];
  if (!primed) {
    DMA_K(0, 0); DMA_V(0, 0); DMA_K(1, SLOTB);
    #pragma unroll
    for (int d0 = 0; d0 < 4; ++d0) qr[d0] = *reinterpret_cast<const bf16x8*>(&Qw[(long)r32 * D + d0 * 16 + hi * 8]);
  } else {
    DMA_V(0, 0);
    #pragma unroll
    for (int d0 = 0; d0 < 4; ++d0) qr[d0] = qc[d0];
  }
  float l_reg = 0.f; f32x16 o[2]; o[0] = f32x16{}; o[1] = f32x16{}; const f32x16 negm = f32x16{};
  #define START(P0, P1) do { _Pragma("unroll") for (int r = 0; r < 16; ++r) P0[r] = __builtin_amdgcn_exp2f(P0[r]); } while (0)
  #define RESC() do { } while (0)
  f32x16 pA0, pA1, pB0, pB1;
  int sl_prev = 0, sl_cur = 0, sl_next = SLOTB;
  #define ROT() do { sl_prev = sl_cur; sl_cur = sl_next; sl_next = (sl_next == (NSLOT - 1) * SLOTB) ? 0 : sl_next + SLOTB; } while (0)
  if (!primed) DMA_K(2, 2 * SLOTB);
  WAIT_BAR(3);
  qkt(pA0, pA1, Kbase, qr, negm, r32, hi); asm volatile("s_nop 15\n\ts_nop 7" : "+v"(pA0), "+v"(pA1));
  START(pA0, pA1);
  _Pragma("unroll") for (int r = 0; r < 16; ++r) pA1[r] = __builtin_amdgcn_exp2f(pA1[r]);
  WAIT_BAR(0);
  DMA_K(3, 0); DMA_V(1, SLOTB);
  ROT();
  kload8(kf, kp0 + sl_cur);
  WAIT_BAR(2);
  s16x4 vlo[8], vhi[8]; u32x4 pw0, pw1, pw2, pw3;
  #define PKW(P, B) cvtpk_s(P[B], P[B + 1])
  #define PAF(k) __builtin_bit_cast(bf16x8, pw##k)
  #define VFR(i) (bf16x8){vlo[i][0], vlo[i][1], vlo[i][2], vlo[i][3], vhi[i][0], vhi[i][1], vhi[i][2], vhi[i][3]}
  #define PIN(x) asm volatile("" : "+v"(x))
  #define MX3(a, b, c) __builtin_fmaxf(__builtin_fmaxf((a), (b)), (c))
  #define GAPA(MF, A0, A1, A2, A3, W0, W1, PW) do { MF; sacc += A0; sacc += A1; sacc += A2; sacc += A3; PIN(sacc); W0; W1; PIN(PW); SBAR(); } while (0)
  #define EX(v) __builtin_amdgcn_exp2f(v)
  #define GAPB(MF, X, B) do { MF; X[B] = EX(X[B]); X[B + 1] = EX(X[B + 1]); X[B + 2] = EX(X[B + 2]); X[B + 3] = EX(X[B + 3]); PIN(X); SBAR(); } while (0)
  #define VRD(i) do { vlo[i] = vtr(vp_ + (((i) >> 2) * 4096 + ((i) & 3) * 1024)); vhi[i] = vtr(vp_ + (((i) >> 2) * 4096 + ((i) & 3) * 1024 + 512)); } while (0)
  #define KRD(G, j) do { if (G) { kload2(kf, kp0 + sl_next, j); SBAR(); } } while (0)
  #define STEP(C0, C1, P0, P1, t, GK, GV, GL) do { SBAR(); \
    const lds_cptr vp_ = vp0 + sl_prev; \
    VRD(0); SBAR(); float sacc = (P0[0] + P0[1]); \
    GAPA(C0 = __builtin_amdgcn_mfma_f32_32x32x16_bf16(kf[0], qr[0], negm, 0, 0, 0), P0[2], P0[3], P0[4], P0[5],     pw0[0] = PKW(P0, 0), pw0[1] = PKW(P0, 2), pw0); \
    VRD(4); SBAR(); GAPA(C1 = __builtin_amdgcn_mfma_f32_32x32x16_bf16(kf[1], qr[0], negm, 0, 0, 0), P0[6], P0[7], P0[8], P0[9],     pw0[2] = PKW(P0, 4), pw0[3] = PKW(P0, 6), pw0); \
    VRD(1); SBAR(); GAPA(C0 = __builtin_amdgcn_mfma_f32_32x32x16_bf16(kf[2], qr[1], C0, 0, 0, 0),   P0[10], P0[11], P0[12], P0[13], pw1[0] = PKW(P0, 8), pw1[1] = PKW(P0, 10), pw1); \
    VRD(5); SBAR(); GAPA(C1 = __builtin_amdgcn_mfma_f32_32x32x16_bf16(kf[3], qr[1], C1, 0, 0, 0),   P0[14], P0[15], P1[0], P1[1],   pw1[2] = PKW(P0, 12), pw1[3] = PKW(P0, 14), pw1); \
    VRD(2); SBAR(); GAPA(C0 = __builtin_amdgcn_mfma_f32_32x32x16_bf16(kf[4], qr[2], C0, 0, 0, 0),   P1[2], P1[3], P1[4], P1[5],     pw2[0] = PKW(P1, 0), pw2[1] = PKW(P1, 2), pw2); \
    VRD(6); SBAR(); GAPA(C1 = __builtin_amdgcn_mfma_f32_32x32x16_bf16(kf[5], qr[2], C1, 0, 0, 0),   P1[6], P1[7], P1[8], P1[9],     pw2[2] = PKW(P1, 4), pw2[3] = PKW(P1, 6), pw2); \
    VRD(3); SBAR(); GAPA(C0 = __builtin_amdgcn_mfma_f32_32x32x16_bf16(kf[6], qr[3], C0, 0, 0, 0),   P1[10], P1[11], P1[12], P1[13], pw3[0] = PKW(P1, 8), pw3[1] = PKW(P1, 10), pw3); \
    VRD(7); SBAR(); GAPA(C1 = __builtin_amdgcn_mfma_f32_32x32x16_bf16(kf[7], qr[3], C1, 0, 0, 0),   P1[14], P1[15], 0.f, 0.f,       pw3[2] = PKW(P1, 12), pw3[3] = PKW(P1, 14), pw3); \
    l_reg += sacc; \
    if (GK) { DMA_K((t) + 3, sl_cur); } if (GV) { DMA_V((t) + 1, sl_next); } \
    SBAR(); \
    GAPB(o[0] = __builtin_amdgcn_mfma_f32_32x32x16_bf16(PAF(0), VFR(0), o[0], 0, 0, 0), C0, 0); \
    GAPB(o[1] = __builtin_amdgcn_mfma_f32_32x32x16_bf16(PAF(0), VFR(4), o[1], 0, 0, 0), C0, 4); \
    KRD(GL, 0); GAPB(o[0] = __builtin_amdgcn_mfma_f32_32x32x16_bf16(PAF(1), VFR(1), o[0], 0, 0, 0), C0, 8); \
    KRD(GL, 1); GAPB(o[1] = __builtin_amdgcn_mfma_f32_32x32x16_bf16(PAF(1), VFR(5), o[1], 0, 0, 0), C0, 12); \
    KRD(GL, 2); GAPB(o[0] = __builtin_amdgcn_mfma_f32_32x32x16_bf16(PAF(2), VFR(2), o[0], 0, 0, 0), C1, 0); \
    KRD(GL, 3); GAPB(o[1] = __builtin_amdgcn_mfma_f32_32x32x16_bf16(PAF(2), VFR(6), o[1], 0, 0, 0), C1, 4); \
    GAPB(o[0] = __builtin_amdgcn_mfma_f32_32x32x16_bf16(PAF(3), VFR(3), o[0], 0, 0, 0), C1, 8); \
    GAPB(o[1] = __builtin_amdgcn_mfma_f32_32x32x16_bf16(PAF(3), VFR(7), o[1], 0, 0, 0), C1, 12); \
    } while (0)
  int t = 1;
  for (; t + 5 < NT; t += 2) {
    STEP(pB0, pB1, pA0, pA1, t, true, true, true);     WAIT_BAR(2); RESC(); ROT();
    STEP(pA0, pA1, pB0, pB1, t + 1, true, true, true); WAIT_BAR(2); RESC(); ROT();
  }
  #define ENDW(tt) do { if ((tt) + 3 < NT) { WAIT_BAR(2); } else if ((tt) + 2 < NT) { WAIT_BAR(1); } else { WAIT_BAR(0); } } while (0)
  for (; t + 1 < NT; t += 2) {
    STEP(pB0, pB1, pA0, pA1, t, (t + 3 < NT), (t + 1 < NT), (t + 1 < NT));         ENDW(t);     RESC(); ROT();
    STEP(pA0, pA1, pB0, pB1, t + 1, (t + 4 < NT), (t + 2 < NT), (t + 2 < NT));     ENDW(t + 1); RESC(); ROT();
  }
  if (Knext) { const bf16* kn = Knext + (long)lane * D + wid * 8;
    glds16(kn, (unsigned)__builtin_amdgcn_readfirstlane(kdst)); glds16(kn + (long)KVBLK * D, (unsigned)__builtin_amdgcn_readfirstlane(kdst + SLOTB)); glds16(kn + (long)2 * KVBLK * D, (unsigned)__builtin_amdgcn_readfirstlane(kdst + 2 * SLOTB)); }
  STEP(pB0, pB1, pA0, pA1, NT - 1, false, false, false); RESC();
  { float sacc = pB0[0] + pB0[1]; _Pragma("unroll") for (int r = 2; r < 16; ++r) sacc += pB0[r]; _Pragma("unroll") for (int r = 0; r < 16; ++r) sacc += pB1[r]; l_reg += sacc;
    pw0 = (u32x4){PKW(pB0, 0), PKW(pB0, 2), PKW(pB0, 4), PKW(pB0, 6)}; pw1 = (u32x4){PKW(pB0, 8), PKW(pB0, 10), PKW(pB0, 12), PKW(pB0, 14)}; pw2 = (u32x4){PKW(pB1, 0), PKW(pB1, 2), PKW(pB1, 4), PKW(pB1, 6)}; pw3 = (u32x4){PKW(pB1, 8), PKW(pB1, 10), PKW(pB1, 12), PKW(pB1, 14)};
    SBAR(); pv(o, vb0 + sl_cur, PAF(0), PAF(1), PAF(2), PAF(3)); }
  if (Qnext) { const bf16* Qn = Qnext + (long)(wid * QBLK) * D;
    #pragma unroll
    for (int d0 = 0; d0 < 4; ++d0) qc[d0] = *reinterpret_cast<const bf16x8*>(&Qn[(long)r32 * D + d0 * 16 + hi * 8]); }
  else {
    #pragma unroll
    for (int d0 = 0; d0 < 4; ++d0) qc[d0] = bf16x8{}; }
  #undef PKW
  #undef PAF
  #undef VFR
  #undef PIN
  #undef MX3
  #undef GAPA
  #undef GAPB
  #undef EX
  #undef VRD
  #undef KRD
  #undef STEP
  #undef ENDW
  { auto rr = __builtin_amdgcn_permlane32_swap(__float_as_uint(l_reg), __float_as_uint(l_reg), false, false); l_reg = __uint_as_float(rr[0]) + __uint_as_float(rr[1]); }
  if (hi == 0) wsf[32 + r32] = l_reg; asm volatile("s_waitcnt lgkmcnt(0)" ::: "memory");
  float rli[16];
  #pragma unroll
  for (int r = 0; r < 16; ++r) rli[r] = __builtin_amdgcn_rcpf(wsf[32 + crow(r, hi)]);
  bf16* Ow = Orows + (long)(wid * QBLK) * opitch;
  { bf16* stg = (bf16*)(shm + LDS_OST) + wid * 2048;
    #pragma unroll
    for (int r = 0; r < 16; ++r) { const int orow = crow(r, hi);
      #pragma unroll
      for (int d0 = 0; d0 < 2; ++d0) stg[orow * 64 + d0 * 32 + r32] = __float2bfloat16(o[d0][r] * rli[r]); }
    asm volatile("s_waitcnt lgkmcnt(0)" ::: "memory");
    #pragma unroll
    for (int i = 0; i < 4; ++i) { const int row = i * 8 + (lane >> 3), ch = lane & 7; const u32x4 v = *(const u32x4*)(stg + row * 64 + ch * 8); *(u32x4*)(Ow + (long)row * opitch + ch * 8) = v; } }
  asm volatile("s_waitcnt lgkmcnt(0)\n\ts_barrier" ::: "memory");
  #undef DMA_K
  #undef DMA_V
  #undef START
  #undef RESC
  #undef ROT
}
template <int THRL> __device__ __forceinline__ void attn_unit_v128(const bf16* Qrows, const bf16* __restrict__ Kh, const bf16* __restrict__ Vh0, const bf16* __restrict__ Vh1, bf16* Orows, int opitch, char* shm,
                                                                   const int primed, const bf16* Qnext, const bf16* Knext, bf16x8 (&qc)[4]) {
  constexpr int L2_K = 0, L2_V = 3 * 8192, L2_WS = L2_V + 3 * 16384, L2_OST = L2_WS + NW * 64 * 4;
  const f32x16 zero16 = f32x16{};
  int tid_ = threadIdx.x; asm volatile("" : "+v"(tid_));
  const int tid = tid_, lane = tid & 63, r32 = lane & 31, hi = lane >> 5; const int wid = __builtin_amdgcn_readfirstlane(tid >> 6);
  const bf16* Qw = Qrows + (long)(wid * QBLK) * D;
  const unsigned lds0 = (unsigned)(uintptr_t)shm;
  float* wsf = (float*)(shm + L2_WS) + wid * 64;
  const bf16* ksrc = Kh + (long)lane * D + wid * 8;
  const long voff_ = (long)(16 * (wid & 3) + (lane >> 2)) * D + (wid >> 2) * 32 + (lane & 3) * 8;
  const bf16* vsrc = Vh0 + voff_; const bf16* vsrc1 = Vh1 + voff_;
  const unsigned kdst = lds0 + L2_K + wid * 1024, vdst = lds0 + L2_V + wid * 1024;
  #define DMA_K(t, slot) glds16(ksrc + (long)(t) * KVBLK * D, (unsigned)__builtin_amdgcn_readfirstlane(kdst + (slot)))
  #define DMA_V(t, slot) do { glds16(vsrc + (long)(t) * KVBLK * D, (unsigned)__builtin_amdgcn_readfirstlane(vdst + 2 * (slot))); \
                               glds16(vsrc1 + (long)(t) * KVBLK * D, (unsigned)__builtin_amdgcn_readfirstlane(vdst + 2 * (slot) + 8192)); } while (0)
  const char* Kbase = shm + L2_K; bf16x8 kf[8];
  const lds_cptr shm3 = (lds_cptr)shm; const lds_cptr kp0 = shm3 + L2_K + hi * 1024 + r32 * 16; const lds_cptr vp0 = shm3 + L2_V + ((lane >> 4) & 1) * 32 + (lane & 3) * 8 + (4 * hi + ((lane & 15) >> 2)) * 64;
  bf16x8 qr[4];
  if (!primed) {
    DMA_K(0, 0); DMA_V(0, 0); DMA_K(1, SLOTB);
    #pragma unroll
    for (int d0 = 0; d0 < 4; ++d0) qr[d0] = *reinterpret_cast<const bf16x8*>(&Qw[(long)r32 * D + d0 * 16 + hi * 8]);
  } else {
    DMA_V(0, 0);
    #pragma unroll
    for (int d0 = 0; d0 < 4; ++d0) qr[d0] = qc[d0];
  }
  float l_reg = 0.f; f32x16 o[4]; o[0] = f32x16{}; o[1] = f32x16{}; o[2] = f32x16{}; o[3] = f32x16{};
  #define START(P0, P1) do { _Pragma("unroll") for (int r = 0; r < 16; ++r) P0[r] = __builtin_amdgcn_exp2f(P0[r]); } while (0)
  #define RESC() do { } while (0)
  f32x16 pA0, pA1, pB0, pB1;
  int sl_prev = 0, sl_cur = 0, sl_next = SLOTB;
  #define ROT() do { sl_prev = sl_cur; sl_cur = sl_next; sl_next = (sl_next == (NSLOT - 1) * SLOTB) ? 0 : sl_next + SLOTB; } while (0)
  if (!primed) DMA_K(2, 2 * SLOTB);
  WAIT_BAR(4);
  { const f32x16 zero_ = f32x16{}; qkt(pA0, pA1, Kbase, qr, zero_, r32, hi); } asm volatile("s_nop 15\n\ts_nop 7" : "+v"(pA0), "+v"(pA1));
  START(pA0, pA1);
  _Pragma("unroll") for (int r = 0; r < 16; ++r) pA1[r] = __builtin_amdgcn_exp2f(pA1[r]);
  WAIT_BAR(0);
  DMA_K(3, 0); DMA_V(1, SLOTB);
  ROT();
  kload8(kf, kp0 + sl_cur);
  WAIT_BAR(3);
  s16x4 vlo[8], vhi[8]; u32x4 pw0, pw1, pw2, pw3;
  #define PKW(P, B) cvtpk_s(P[B], P[B + 1])
  #define PAF(k) __builtin_bit_cast(bf16x8, pw##k)
  #define VFR(i) (bf16x8){vlo[i][0], vlo[i][1], vlo[i][2], vlo[i][3], vhi[i][0], vhi[i][1], vhi[i][2], vhi[i][3]}
  #define PIN(x) asm volatile("" : "+v"(x))
  #define MX3(a, b, c) __builtin_fmaxf(__builtin_fmaxf((a), (b)), (c))
  #define GAPA(MF, A0, A1, A2, A3, W0, W1, PW) do { MF; sacc += A0; sacc += A1; sacc += A2; sacc += A3; PIN(sacc); W0; W1; PIN(PW); SBAR(); } while (0)
  #define EX(v) __builtin_amdgcn_exp2f(v)
  #define GAPB(MF, X, B) do { MF; X[B] = EX(X[B]); X[B + 1] = EX(X[B + 1]); PIN(X); SBAR(); } while (0)
  #define VRD(c) do { vlo[(c) & 7] = vtr(vp_ + (((c) & 3) * 4096 + ((c) >> 2) * 1024)); vhi[(c) & 7] = vtr(vp_ + (((c) & 3) * 4096 + ((c) >> 2) * 1024 + 512)); } while (0)
  #define KRD(G, j) do { if (G) { kload2(kf, kp0 + sl_next, j); SBAR(); } } while (0)
  #define PVM(c, X, B) GAPB(o[(c) & 3] = __builtin_amdgcn_mfma_f32_32x32x16_bf16(PAFI((c) >> 2), VFR((c) & 7), o[(c) & 3], 0, 0, 0), X, B)
  #define PAFI(k) ((k) == 0 ? PAF(0) : (k) == 1 ? PAF(1) : (k) == 2 ? PAF(2) : PAF(3))
  #define STEP(C0, C1, P0, P1, t, GK, GV, GL) do { SBAR(); \
    const lds_cptr vp_ = vp0 + 2 * sl_prev; \
    VRD(0); SBAR(); float sacc = (P0[0] + P0[1]); \
    GAPA(C0 = __builtin_amdgcn_mfma_f32_32x32x16_bf16(kf[0], qr[0], zero16, 0, 0, 0), P0[2], P0[3], P0[4], P0[5],     pw0[0] = PKW(P0, 0), pw0[1] = PKW(P0, 2), pw0); \
    VRD(1); SBAR(); GAPA(C1 = __builtin_amdgcn_mfma_f32_32x32x16_bf16(kf[1], qr[0], zero16, 0, 0, 0), P0[6], P0[7], P0[8], P0[9],     pw0[2] = PKW(P0, 4), pw0[3] = PKW(P0, 6), pw0); \
    VRD(2); SBAR(); GAPA(C0 = __builtin_amdgcn_mfma_f32_32x32x16_bf16(kf[2], qr[1], C0, 0, 0, 0),   P0[10], P0[11], P0[12], P0[13], pw1[0] = PKW(P0, 8), pw1[1] = PKW(P0, 10), pw1); \
    VRD(3); SBAR(); GAPA(C1 = __builtin_amdgcn_mfma_f32_32x32x16_bf16(kf[3], qr[1], C1, 0, 0, 0),   P0[14], P0[15], P1[0], P1[1],   pw1[2] = PKW(P0, 12), pw1[3] = PKW(P0, 14), pw1); \
    VRD(4); SBAR(); GAPA(C0 = __builtin_amdgcn_mfma_f32_32x32x16_bf16(kf[4], qr[2], C0, 0, 0, 0),   P1[2], P1[3], P1[4], P1[5],     pw2[0] = PKW(P1, 0), pw2[1] = PKW(P1, 2), pw2); \
    VRD(5); SBAR(); GAPA(C1 = __builtin_amdgcn_mfma_f32_32x32x16_bf16(kf[5], qr[2], C1, 0, 0, 0),   P1[6], P1[7], P1[8], P1[9],     pw2[2] = PKW(P1, 4), pw2[3] = PKW(P1, 6), pw2); \
    VRD(6); SBAR(); GAPA(C0 = __builtin_amdgcn_mfma_f32_32x32x16_bf16(kf[6], qr[3], C0, 0, 0, 0),   P1[10], P1[11], P1[12], P1[13], pw3[0] = PKW(P1, 8), pw3[1] = PKW(P1, 10), pw3); \
    VRD(7); SBAR(); GAPA(C1 = __builtin_amdgcn_mfma_f32_32x32x16_bf16(kf[7], qr[3], C1, 0, 0, 0),   P1[14], P1[15], 0.f, 0.f,       pw3[2] = PKW(P1, 12), pw3[3] = PKW(P1, 14), pw3); \
    l_reg += sacc; \
    if (GK) { DMA_K((t) + 3, sl_cur); } if (GV) { DMA_V((t) + 1, sl_next); } \
    SBAR(); \
    PVM(0, C0, 0);  VRD(8);  SBAR(); \
    PVM(1, C0, 2);  VRD(9);  SBAR(); \
    PVM(2, C0, 4);  VRD(10); SBAR(); \
    PVM(3, C0, 6);  VRD(11); SBAR(); \
    KRD(GL, 0); PVM(4, C0, 8);  VRD(12); SBAR(); \
    PVM(5, C0, 10); VRD(13); SBAR(); \
    KRD(GL, 1); PVM(6, C0, 12); VRD(14); SBAR(); \
    PVM(7, C0, 14); VRD(15); SBAR(); \
    KRD(GL, 2); PVM(8, C1, 0); \
    PVM(9, C1, 2); \
    KRD(GL, 3); PVM(10, C1, 4); \
    PVM(11, C1, 6); \
    PVM(12, C1, 8); \
    PVM(13, C1, 10); \
    PVM(14, C1, 12); \
    PVM(15, C1, 14); \
    } while (0)
  int t = 1;
  for (; t + 5 < NT; t += 2) {
    STEP(pB0, pB1, pA0, pA1, t, true, true, true);     WAIT_BAR(3); RESC(); ROT();
    STEP(pA0, pA1, pB0, pB1, t + 1, true, true, true); WAIT_BAR(3); RESC(); ROT();
  }
  #define ENDW(tt) do { if ((tt) + 3 < NT) { WAIT_BAR(3); } else if ((tt) + 2 < NT) { WAIT_BAR(2); } else { WAIT_BAR(0); } } while (0)
  for (; t + 1 < NT; t += 2) {
    STEP(pB0, pB1, pA0, pA1, t, (t + 3 < NT), (t + 1 < NT), (t + 1 < NT));         ENDW(t);     RESC(); ROT();
    STEP(pA0, pA1, pB0, pB1, t + 1, (t + 4 < NT), (t + 2 < NT), (t + 2 < NT));     ENDW(t + 1); RESC(); ROT();
  }
  if (Knext) { const bf16* kn = Knext + (long)lane * D + wid * 8;
    glds16(kn, (unsigned)__builtin_amdgcn_readfirstlane(kdst)); glds16(kn + (long)KVBLK * D, (unsigned)__builtin_amdgcn_readfirstlane(kdst + SLOTB)); glds16(kn + (long)2 * KVBLK * D, (unsigned)__builtin_amdgcn_readfirstlane(kdst + 2 * SLOTB)); }
  STEP(pB0, pB1, pA0, pA1, NT - 1, false, false, false); RESC();
  { float sacc = pB0[0] + pB0[1]; _Pragma("unroll") for (int r = 2; r < 16; ++r) sacc += pB0[r]; _Pragma("unroll") for (int r = 0; r < 16; ++r) sacc += pB1[r]; l_reg += sacc;
    pw0 = (u32x4){PKW(pB0, 0), PKW(pB0, 2), PKW(pB0, 4), PKW(pB0, 6)}; pw1 = (u32x4){PKW(pB0, 8), PKW(pB0, 10), PKW(pB0, 12), PKW(pB0, 14)}; pw2 = (u32x4){PKW(pB1, 0), PKW(pB1, 2), PKW(pB1, 4), PKW(pB1, 6)}; pw3 = (u32x4){PKW(pB1, 8), PKW(pB1, 10), PKW(pB1, 12), PKW(pB1, 14)};
    SBAR(); const lds_cptr vp_ = vp0 + 2 * sl_cur;
    _Pragma("unroll") for (int c = 0; c < 16; ++c) { const s16x4 lo_ = vtr(vp_ + ((c & 3) * 4096 + (c >> 2) * 1024)), hi_ = vtr(vp_ + ((c & 3) * 4096 + (c >> 2) * 1024 + 512));
      const bf16x8 vf_ = (bf16x8){lo_[0], lo_[1], lo_[2], lo_[3], hi_[0], hi_[1], hi_[2], hi_[3]};
      o[c & 3] = __builtin_amdgcn_mfma_f32_32x32x16_bf16(PAFI(c >> 2), vf_, o[c & 3], 0, 0, 0); } }
  if (Qnext) { const bf16* Qn = Qnext + (long)(wid * QBLK) * D;
    #pragma unroll
    for (int d0 = 0; d0 < 4; ++d0) qc[d0] = *reinterpret_cast<const bf16x8*>(&Qn[(long)r32 * D + d0 * 16 + hi * 8]); }
  else {
    #pragma unroll
    for (int d0 = 0; d0 < 4; ++d0) qc[d0] = bf16x8{}; }
  #undef PKW
  #undef PAF
  #undef VFR
  #undef PIN
  #undef MX3
  #undef GAPA
  #undef GAPB
  #undef EX
  #undef VRD
  #undef KRD
  #undef STEP
  #undef ENDW
  #undef PVM
  #undef PAFI
  { auto rr = __builtin_amdgcn_permlane32_swap(__float_as_uint(l_reg), __float_as_uint(l_reg), false, false); l_reg = __uint_as_float(rr[0]) + __uint_as_float(rr[1]); }
  if (hi == 0) wsf[32 + r32] = l_reg; asm volatile("s_waitcnt lgkmcnt(0)" ::: "memory");
  float rli[16];
  #pragma unroll
  for (int r = 0; r < 16; ++r) rli[r] = __builtin_amdgcn_rcpf(wsf[32 + crow(r, hi)]);
  bf16* Ow = Orows + (long)(wid * QBLK) * opitch;
  { bf16* stg = (bf16*)(shm + L2_OST) + wid * 2048;
    #pragma unroll
    for (int hf = 0; hf < 2; ++hf) {
      #pragma unroll
      for (int r = 0; r < 16; ++r) { const int orow = crow(r, hi);
        #pragma unroll
        for (int d0 = 0; d0 < 2; ++d0) stg[orow * 64 + d0 * 32 + r32] = __float2bfloat16(o[hf * 2 + d0][r] * rli[r]); }
      asm volatile("s_waitcnt lgkmcnt(0)" ::: "memory");
      #pragma unroll
      for (int i = 0; i < 4; ++i) { const int row = i * 8 + (lane >> 3), ch = lane & 7; const u32x4 v = *(const u32x4*)(stg + row * 64 + ch * 8); *(u32x4*)(Ow + (long)row * opitch + hf * 64 + ch * 8) = v; }
      asm volatile("s_waitcnt lgkmcnt(0)" ::: "memory");
    } }
  asm volatile("s_waitcnt lgkmcnt(0)\n\ts_barrier" ::: "memory");
  #undef DMA_K
  #undef DMA_V
  #undef START
  #undef RESC
  #undef ROT
}
#undef SBAR
#undef WAIT_BAR
}

struct P0Item { const float* src; const float* ks; unsigned char* dst; int ldw; int fp8; };
__device__ __forceinline__ void p0_load(const P0Item& I, f32x4 (&v)[8], float (&sc)[8], int lane) {
#pragma unroll
    for (int i = 0; i < 8; ++i) { const int kk = (lane >> 3) + 8 * i; v[i] = __builtin_nontemporal_load((const f32x4*)(I.src + (size_t)kk * I.ldw + 4 * (lane & 7))); sc[i] = I.ks ? I.ks[kk] : 1.0f; }
}
__device__ __forceinline__ void p0_process(const P0Item& I, const f32x4 (&v)[8], const float (&sc)[8], LAS float* scr, int lane) {
    const float mul = I.fp8 ? 64.0f : 1.0f;
#pragma unroll
    for (int i = 0; i < 8; ++i) { const int kk = (lane >> 3) + 8 * i; const f32x4 w = v[i] * (sc[i] * mul);
        LAS float* s = scr + kk * 33 + 4 * (lane & 7); s[0] = w[0]; s[1] = w[1]; s[2] = w[2]; s[3] = w[3]; }
    asm volatile("s_waitcnt lgkmcnt(0)" ::: "memory");
    const int c = lane & 7;
    if (I.fp8) {
#pragma unroll
        for (int j = 0; j < 4; ++j) { const int n = (lane >> 3) + 8 * j; const LAS float* s = scr + (8 * c) * 33 + n;
            u32x2 o; o.x = pk4_fp8_nc(s[0 * 33], s[1 * 33], s[2 * 33], s[3 * 33]); o.y = pk4_fp8_nc(s[4 * 33], s[5 * 33], s[6 * 33], s[7 * 33]);
            *(u32x2*)(I.dst + (size_t)n * KDIM + 8 * c) = o; }
    } else {
#pragma unroll
        for (int j = 0; j < 4; ++j) { const int n = (lane >> 3) + 8 * j; const LAS float* s = scr + (8 * c) * 33 + n;
            u32x4 o; o.x = cvt_pk_bf16(s[0 * 33], s[1 * 33]); o.y = cvt_pk_bf16(s[2 * 33], s[3 * 33]); o.z = cvt_pk_bf16(s[4 * 33], s[5 * 33]); o.w = cvt_pk_bf16(s[6 * 33], s[7 * 33]);
            *(u32x4*)(I.dst + (size_t)n * KDIM * 2 + 16 * c) = o; }
    }
    asm volatile("s_waitcnt lgkmcnt(0)" ::: "memory");
}
constexpr int P0_IN = 16 * 72, P0_OUT = 16 * 32, P0_GU = NEXP * 16 * 64, P0_DN = NEXP * 16 * 32, P0_NITEMS = P0_IN + P0_OUT + P0_GU + P0_DN;
__device__ __forceinline__ P0Item p0_decode(const Frame& F, int it) {
    P0Item I; int r = it;
    if (r < P0_IN) { const int kb = r / 72, nb = r % 72, pn = nb >> 3, bj = (nb >> 2) & 1, wc = nb & 3;
        I.src = F.in[I_WIN] + (size_t)(64 * kb) * NPROJ + 256 * pn + 64 * wc + 32 * bj; I.ldw = NPROJ; I.ks = F.in[I_N1G] + 64 * kb; I.fp8 = 0;
        I.dst = F.ws + WS_WIN + ((size_t)(32 * nb) * KDIM + 64 * kb) * 2; return I; }
    r -= P0_IN;
    if (r < P0_OUT) { const int kb = r / 32, nb = r % 32;
        I.src = F.in[I_WOUT] + (size_t)(64 * kb) * DMODEL + 32 * nb; I.ldw = DMODEL; I.ks = nullptr; I.fp8 = 0;
        I.dst = F.ws + WS_WOUT + ((size_t)(32 * nb) * KDIM + 64 * kb) * 2; return I; }
    r -= P0_OUT;
    if (r < P0_GU) { const int e = r >> 10, q = r & 1023, kb = q >> 6, nb = q & 63, pn = nb >> 3, bj = (nb >> 2) & 1, jb = nb & 3;
        I.src = (bj ? F.in[I_WU] : F.in[I_WG]) + (size_t)e * DMODEL * DEXP + (size_t)(64 * kb) * DEXP + 128 * pn + 32 * jb; I.ldw = DEXP; I.ks = F.in[I_N2G] + 64 * kb; I.fp8 = 1;
        I.dst = F.ws + WS_WGU + ((size_t)e * 2048 + 32 * nb) * KDIM + 64 * kb; return I; }
    r -= P0_GU;
    { const int e = r >> 9, q = r & 511, kb = q >> 5, nb = q & 31;
        I.src = F.in[I_WDN] + (size_t)e * DEXP * DMODEL + (size_t)(64 * kb) * DMODEL + 32 * nb; I.ldw = DMODEL; I.ks = nullptr; I.fp8 = 1;
        I.dst = F.ws + WS_WD + ((size_t)e * 1024 + 32 * nb) * KDIM + 64 * kb; return I; }
}
__device__ __forceinline__ void p0_convert_range(const Frame& F, int it0, int it1, int w, int nw, LAS float* scr, int lane) {
    int it = it0 + w;
    if (it < it1) {
        P0Item A = p0_decode(F, it), B = A; f32x4 va[8], vb[8]; float sa[8], sb[8];
        p0_load(A, va, sa, lane);
        for (;;) {
            const bool hb = it + nw < it1; if (hb) { B = p0_decode(F, it + nw); p0_load(B, vb, sb, lane); }
            p0_process(A, va, sa, scr, lane);
            if (!hb) break; it += nw;
            const bool ha = it + nw < it1; if (ha) { A = p0_decode(F, it + nw); p0_load(A, va, sa, lane); }
            p0_process(B, vb, sb, scr, lane);
            if (!ha) break; it += nw;
        }
    }
}
__device__ __forceinline__ void p0_prologue(Frame& F) {
    LAS float* scr = (LAS float*)(F.lds + F.wave * 16384);
    const int gw = F.vcu * NWAVES + F.wave, NGW = F.G * NWAVES, lane = F.lane;
    p0_convert_range(F, 0, P0_IN + P0_OUT, gw, NGW, scr, lane);
    { bf16_t* XN = (bf16_t*)(F.ws + WS_XN); float* sig = (float*)(F.ws + WS_SIG);
      for (int m = gw; m < MTOK; m += 2 * NGW) {
          const int m2 = m + NGW; const bool h2 = m2 < MTOK;
          const float* xr = F.in[I_X] + (size_t)m * DMODEL + 8 * lane; const float* xr2 = F.in[I_X] + (size_t)(h2 ? m2 : m) * DMODEL + 8 * lane;
          f32x4 v[4], w[4]; float s = 0.f, s2 = 0.f;
#pragma unroll
          for (int j = 0; j < 2; ++j) { v[2 * j] = __builtin_nontemporal_load((const f32x4*)(xr + 512 * j)); v[2 * j + 1] = __builtin_nontemporal_load((const f32x4*)(xr + 512 * j + 4));
                                        w[2 * j] = __builtin_nontemporal_load((const f32x4*)(xr2 + 512 * j)); w[2 * j + 1] = __builtin_nontemporal_load((const f32x4*)(xr2 + 512 * j + 4)); }
#pragma unroll
          for (int j = 0; j < 4; ++j) { s += (v[j].x * v[j].x + v[j].y * v[j].y) + (v[j].z * v[j].z + v[j].w * v[j].w); s2 += (w[j].x * w[j].x + w[j].y * w[j].y) + (w[j].z * w[j].z + w[j].w * w[j].w); }
          const float sg = sqrtf(wave_sum(s) * (1.0f / DMODEL) + EPS), sg2 = sqrtf(wave_sum(s2) * (1.0f / DMODEL) + EPS);
          const float rstd = 1.0f / sg, rstd2 = 1.0f / sg2;
          bf16_t* o8 = XN + (size_t)m * DMODEL + 8 * lane; bf16_t* o82 = XN + (size_t)m2 * DMODEL + 8 * lane;
#pragma unroll
          for (int j = 0; j < 2; ++j) { const f32x4 y0 = v[2 * j] * rstd, y1 = v[2 * j + 1] * rstd; u32x4 t; t.x = cvt_pk_bf16(y0.x, y0.y); t.y = cvt_pk_bf16(y0.z, y0.w); t.z = cvt_pk_bf16(y1.x, y1.y); t.w = cvt_pk_bf16(y1.z, y1.w); *(u32x4*)(o8 + 512 * j) = t; }
          if (lane == 0) sig[m] = sg;
          if (h2) {
#pragma unroll
              for (int j = 0; j < 2; ++j) { const f32x4 y0 = w[2 * j] * rstd2, y1 = w[2 * j + 1] * rstd2; u32x4 t; t.x = cvt_pk_bf16(y0.x, y0.y); t.y = cvt_pk_bf16(y0.z, y0.w); t.z = cvt_pk_bf16(y1.x, y1.y); t.w = cvt_pk_bf16(y1.z, y1.w); *(u32x4*)(o82 + 512 * j) = t; }
              if (lane == 0) sig[m2] = sg2; }
      } }
    if (blockIdx.x == 0 && F.tid < 64) { float* tab = (float*)(F.ws + WS_TAB); const int i = F.tid & 31;
        const float f = (F.tid < 32) ? powf(10000.0f, -(float)(2 * i) / 64.0f) : powf(10000.0f, -(float)(2 * (i & 15)) / 32.0f);
        tab[F.tid] = (float)((double)f * 0.15915494309189535); }
    { unsigned char* wr = F.ws + WS_WR; const float* rw = F.in[I_RW]; const float* g2 = F.in[I_N2G];
      for (int idx = gw * 64 + lane; idx < DMODEL * NEXP; idx += NGW * 64) { const int k = idx >> 5, e = idx & 31; const float w = rw[idx] * g2[k];
          const unsigned hi = cvt_pk_bf16(w, 0.f) & 0xffffu; const float rem = w - __uint_as_float(hi << 16); const unsigned lo = cvt_pk_bf16(rem, 0.f) & 0xffffu;
          const int off = e * 2048 + (((k >> 3) ^ (e & 15)) << 4) + (k & 7) * 2;
          *(bf16_t*)(wr + off) = (bf16_t)hi; *(bf16_t*)(wr + 65536 + off) = (bf16_t)lo; } }
    if (blockIdx.x == 0) {
        unsigned* ctl = (unsigned*)(F.ws + WS_CTL);
        { float* gnt = (float*)(F.ws + WS_GN);
          if (F.tid < 64) gnt[F.tid] = F.in[I_AQG][F.tid]; else if (F.tid < 128) gnt[F.tid] = F.in[I_AKG][F.tid - 64];
          else if (F.tid < 192) gnt[F.tid] = F.in[I_BQG][F.tid - 128]; else if (F.tid < 256) gnt[F.tid] = F.in[I_BKG][F.tid - 192]; }
        if (F.tid < NBIN) ctl[F.tid] = 0u;
        if (F.tid >= 448) {
            const int i = F.tid - 448;
            const float d1 = wave_sum(F.in[I_LQ1][i] * F.in[I_LK1][i]), d2 = wave_sum(F.in[I_LQ2][i] * F.in[I_LK2][i]);
            if (i == 0) ((float*)ctl)[256] = expf(d1) - expf(d2) + LAM_INIT;
        }
    }
}

__device__ __forceinline__ void p2_attention(Frame& F, char* shm) {
    using abf = attn_body::bf16;
    const abf* QA = (const abf*)(F.ws + WS_QA); const abf* KA = (const abf*)(F.ws + WS_KA); const abf* VA = (const abf*)(F.ws + WS_VA);
    const abf* QB = (const abf*)(F.ws + WS_QB); const abf* KB = (const abf*)(F.ws + WS_KB); const abf* VB = (const abf*)(F.ws + WS_VB);
    abf* CAT = (abf*)(F.ws + WS_CAT); abf* OAPW = (abf*)(F.ws + WS_OAP) + (size_t)blockIdx.x * 131072;
    const size_t HS = (size_t)SEQ * 64;
    auto combine = [&](const abf* OAP, int b, int h, int qb) {
        const float lam = ((const float*)(F.ws + WS_CTL))[256];
        int ctid = threadIdx.x; asm volatile("" : "+v"(ctid));
        const int chunk = ctid & 15, rlo = ctid >> 4;
        const u32x4* p1 = (const u32x4*)((const bf16_t*)OAP + rlo * 128 + chunk * 8); const u32x4* p2 = (const u32x4*)((const bf16_t*)OAP + 32768 + rlo * 128 + chunk * 8);
        const float* sg = F.in[I_SUBG] + chunk * 8;
        const f32x4 g0 = *(const f32x4*)sg, g1 = *(const f32x4*)(sg + 4);
        u32x4 av[8], dv[8];
#pragma unroll
        for (int ps = 0; ps < 8; ++ps) { av[ps] = p1[ps * 512]; dv[ps] = p2[ps * 512]; }
        bf16_t* dst = (bf16_t*)CAT + ((size_t)b * SEQ + qb * 256 + rlo) * DMODEL + h * 128 + chunk * 8;
#pragma unroll
        for (int ps = 0; ps < 8; ++ps) {
            const unsigned aw[4] = {av[ps].x, av[ps].y, av[ps].z, av[ps].w}, dw[4] = {dv[ps].x, dv[ps].y, dv[ps].z, dv[ps].w};
            float ov[8]; float ss = 0.f;
#pragma unroll
            for (int q = 0; q < 4; ++q) { const float lo = bf_lo(aw[q]) - lam * bf_lo(dw[q]), hi2 = bf_hi(aw[q]) - lam * bf_hi(dw[q]); ov[q * 2] = lo; ov[q * 2 + 1] = hi2; ss += lo * lo + hi2 * hi2; }
            ss += xor1f(ss); ss += xor2f(ss); ss += xor4f(ss); ss += xor8f(ss);
            const float rs = __builtin_amdgcn_rsqf(ss * (1.0f / 128.0f) + EPS) * (1.0f - LAM_INIT);
            u32x4 w;
            w.x = cvt_pk_bf16(ov[0] * rs * g0[0], ov[1] * rs * g0[1]); w.y = cvt_pk_bf16(ov[2] * rs * g0[2], ov[3] * rs * g0[3]);
            w.z = cvt_pk_bf16(ov[4] * rs * g1[0], ov[5] * rs * g1[1]); w.w = cvt_pk_bf16(ov[6] * rs * g1[2], ov[7] * rs * g1[3]);
            *(u32x4*)(dst + (size_t)ps * 32 * DMODEL) = w;
        }
    };
    const int conv_slot = F.vcu % 6; int jn = 0; bool conv_done = false;
    int pend = 0, pb = 0, ph = 0, pqb = 0, pbuf = 0;
    bf16x8 qc[4]; int primed = 0;
#pragma unroll
    for (int d0 = 0; d0 < 4; ++d0) qc[d0] = bf16x8{};
    for (int J = F.vcu; J < 1536; J += F.G, ++jn) {
        if (jn == conv_slot) { conv_done = true; __syncthreads();
            { int t_ = threadIdx.x; asm volatile("" : "+v"(t_)); F.tid = t_; F.lane = t_ & 63; }
            p0_convert_range(F, P0_IN + P0_OUT, P0_NITEMS, F.vcu * NWAVES + F.wave, F.G * NWAVES, (LAS float*)(F.lds + F.wave * 16384), F.lane); __syncthreads(); }
        const bool isA = J < 512;
        int b, h = 0, qb, kvh = 0, g = 0;
        if (isA) { const int c = J >> 8, v = J & 255; b = v >> 5; const int w = (c << 5) | (v & 31); h = w >> 4; qb = w & 15; }
        else { const int ui = J - 512, i = ui >> 8, v = ui & 255; b = v >> 5; const int w = i * 32 + (v & 31); kvh = w >> 6; g = (w >> 4) & 3; qb = w & 15; }
        const abf* Qn1 = nullptr; const abf* Kn1 = nullptr;
        { const int Jn = J + F.G;
          if (Jn < 1536 && jn + 1 != conv_slot) {
              if (Jn < 512) { const int c = Jn >> 8, v = Jn & 255, bn = v >> 5, w = (c << 5) | (v & 31), hn = w >> 4, qbn = w & 15;
                  Qn1 = QA + (size_t)(bn * 8 + hn * 2) * HS + (size_t)qbn * 256 * 64; Kn1 = KA + (size_t)(bn * 8 + hn * 2) * HS; }
              else { const int ui = Jn - 512, i = ui >> 8, v = ui & 255, bn = v >> 5, w = i * 32 + (v & 31), kvhn = w >> 6, gn = (w >> 4) & 3, qbn = w & 15;
                  Qn1 = QB + (size_t)(bn * 8 + kvhn * 4 + gn) * HS + (size_t)qbn * 256 * 64; Kn1 = KB + (size_t)(bn * 2 + kvhn) * HS; } } }
        if (isA) {
            abf* OAP = OAPW + (size_t)(jn & 1) * 65536;
            if (pend && pbuf == (jn & 1)) { asm volatile("s_waitcnt vmcnt(0)" ::: "memory"); __syncthreads(); combine(OAPW + (size_t)pbuf * 65536, pb, ph, pqb); pend = 0; asm volatile("s_waitcnt vmcnt(0)" ::: "memory"); __syncthreads(); }
#pragma unroll 1
            for (int br = 0; br < 2; ++br) {
                const abf* Qn = br == 0 ? QA + (size_t)(b * 8 + h * 2 + 1) * HS + (size_t)qb * 256 * 64 : Qn1;
                const abf* Kn = br == 0 ? KA + (size_t)(b * 8 + h * 2 + 1) * HS : Kn1;
                attn_body::attn_unit_v128<8>(QA + (size_t)(b * 8 + h * 2 + br) * HS + (size_t)qb * 256 * 64, KA + (size_t)(b * 8 + h * 2 + br) * HS,
                                             VA + (size_t)(b * 8 + h * 2) * HS, VA + (size_t)(b * 8 + h * 2 + 1) * HS, OAP + br * 32768, 128, shm, primed, Qn, Kn, qc);
                primed = (Kn != nullptr);
                if (br == 0 && pend) { combine(OAPW + (size_t)pbuf * 65536, pb, ph, pqb); pend = 0; }
            }
            pend = 1; pb = b; ph = h; pqb = qb; pbuf = jn & 1;
        } else { const int qh = kvh * 4 + g;
            attn_body::attn_unit<8>(QB + (size_t)(b * 8 + qh) * HS + (size_t)qb * 256 * 64, KB + (size_t)(b * 2 + kvh) * HS, VB + (size_t)(b * 2 + kvh) * HS,
                                    CAT + ((size_t)b * SEQ + qb * 256) * DMODEL + 512 + qh * 64, DMODEL, shm, primed, Qn1, Kn1, qc);
            primed = (Kn1 != nullptr);
            if (pend) { combine(OAPW + (size_t)pbuf * 65536, pb, ph, pqb); pend = 0; }
        }
    }
    if (pend) { asm volatile("s_waitcnt vmcnt(0)" ::: "memory"); __syncthreads(); combine(OAPW + (size_t)pbuf * 65536, pb, ph, pqb); pend = 0; }
    if (!conv_done) { __syncthreads(); { int t_ = threadIdx.x; asm volatile("" : "+v"(t_)); F.tid = t_; F.lane = t_ & 63; } p0_convert_range(F, P0_IN + P0_OUT, P0_NITEMS, F.vcu * NWAVES + F.wave, F.G * NWAVES, (LAS float*)(F.lds + F.wave * 16384), F.lane); __syncthreads(); }
}

__device__ __forceinline__ void p4_fill(Frame& F) {
    int t_ = threadIdx.x; asm volatile("" : "+v"(t_));
    const f32x4* src = (const f32x4*)(F.ws + WS_WR); LAS f32x4* d = (LAS f32x4*)F.lds; for (int i = t_; i < 8192; i += NTHR) d[i] = src[i];
}
__device__ __forceinline__ void p4_route(Frame& F, const bool filled) {
    LAS int* tk_e = (LAS int*)(F.lds + MISC_OFF);
    LAS float* tk_g = (LAS float*)(F.lds + MISC_OFF + 2048);
    LAS int* tk_r = (LAS int*)(F.lds + MISC_OFF + 4096);
    LAS int* lcnt = (LAS int*)(F.lds + MISC_OFF + 6144);
    LAS int* lbase = (LAS int*)(F.lds + MISC_OFF + 6656);
    LAS float* tk_s = (LAS float*)(F.lds + MISC_OFF + 7168);
    const int tid = F.tid, lane = F.lane, wave = F.wave;
    if (!filled) p4_fill(F);
    if (tid < NBIN) lcnt[tid] = 0;
    __syncthreads();
    const bf16_t* x1b = (const bf16_t*)(F.ws + WS_X1B); const float* rb = F.in[I_RB]; int* tokpos = (int*)(F.ws + WS_TP);
    float* rstd_tok = (float*)(F.ws + WS_RSTD); unsigned* gcnt = (unsigned*)(F.ws + WS_CTL);
    int* ent_tok = (int*)(F.ws + WS_ENT); float* ent_gate = (float*)(F.ws + WS_ENT + (size_t)NBIN * CAP * 4);
    using attn_body::f32x16;
    const int e = lane & 31, hi = lane >> 5;
    const float myb = rb[e];
    for (int ch = F.vcu; ch < MTOK / 128; ch += F.G) {
        const int t0 = ch * 128 + wave * 16;
        const bf16_t* xrow = x1b + (size_t)(t0 + (lane & 15)) * DMODEL + 8 * hi;
        const LAS unsigned char* wb = F.lds + e * 2048;
        f32x16 ah = f32x16{}, al = f32x16{}; f32x2 ss2 = (f32x2){0.f, 0.f};
        auto ldx = [&](u32x4 (&v)[8], int k0) {
#pragma unroll
            for (int j = 0; j < 8; ++j) v[j] = *(const u32x4*)(xrow + 16 * (k0 + j)); };
        auto mma8 = [&](const u32x4 (&v)[8], int k0) {
#pragma unroll
            for (int j = 0; j < 8; ++j) {
                const int c = 2 * (k0 + j) + hi;
                const bf16x8 bh = *(const LAS bf16x8*)(wb + ((c ^ (e & 15)) << 4)), bl = *(const LAS bf16x8*)(wb + 65536 + ((c ^ (e & 15)) << 4));
                const bf16x8 a = __builtin_bit_cast(bf16x8, v[j]);
                ah = __builtin_amdgcn_mfma_f32_32x32x16_bf16(a, bh, ah, 0, 0, 0);
                al = __builtin_amdgcn_mfma_f32_32x32x16_bf16(a, bl, al, 0, 0, 0);
                const unsigned aw[4] = {v[j].x, v[j].y, v[j].z, v[j].w};
#pragma unroll
                for (int q = 0; q < 4; ++q) { const f32x2 w = (f32x2){bf_lo(aw[q]), bf_hi(aw[q])}; ss2 += w * w; }
            } };
        u32x4 av[8], bv8[8];
        ldx(av, 0);
#pragma unroll 1
        for (int k0 = 0; k0 < 64; k0 += 16) {
            ldx(bv8, k0 + 8);
            mma8(av, k0);
            if (k0 + 16 < 64) ldx(av, k0 + 16);
            mma8(bv8, k0 + 8);
        }
        float ssum = ss2.x + ss2.y; ssum = sum32f(ssum);
        const float rstd_l = 1.0f / sqrtf(ssum * (1.0f / DMODEL) + EPS);
        if (lane < 16) { tk_s[wave * 16 + lane] = rstd_l; rstd_tok[t0 + lane] = rstd_l; }
        asm volatile("s_waitcnt lgkmcnt(0)" ::: "memory");
        float val[8];
#pragma unroll
        for (int q = 0; q < 8; ++q) val[q] = (ah[q] + al[q]) * tk_s[wave * 16 + attn_body::crow(q, hi)] + myb;
        int se[8][4]; float sv[8][4]; unsigned key[8];
#pragma unroll
        for (int q = 0; q < 8; ++q) { unsigned u = __float_as_uint(val[q]); u = (u & 0x80000000u) ? ~u : (u | 0x80000000u); key[q] = (u & ~31u) | (unsigned)(31 - e); }
#pragma unroll
        for (int k = 0; k < 4; ++k)
#pragma unroll
            for (int q = 0; q < 8; ++q) {
                unsigned m = key[q], o;
                o = (unsigned)dppi<0xB1>((int)m); m = m > o ? m : o; o = (unsigned)xor2i((int)m); m = m > o ? m : o; o = (unsigned)xor4i((int)m); m = m > o ? m : o;
                o = (unsigned)xor8i((int)m); m = m > o ? m : o; o = (unsigned)xor16i((int)m, lane); m = m > o ? m : o;
                se[q][k] = 31 - (int)(m & 31u);
                unsigned u = m & ~31u; u = (u & 0x80000000u) ? (u & 0x7fffffffu) : ~u;
                sv[q][k] = __uint_as_float(u);
                if (key[q] == m) key[q] = 0u;
            }
        if (e == 0) {
#pragma unroll
            for (int q = 0; q < 8; ++q) {
                const int lt = wave * 16 + attn_body::crow(q, hi);
                const float e1 = __expf(sv[q][1] - sv[q][0]), e2 = __expf(sv[q][2] - sv[q][0]), e3 = __expf(sv[q][3] - sv[q][0]); const float inv = 1.0f / (1.0f + e1 + e2 + e3);
                tk_e[lt * 4 + 0] = se[q][0]; tk_e[lt * 4 + 1] = se[q][1]; tk_e[lt * 4 + 2] = se[q][2]; tk_e[lt * 4 + 3] = se[q][3];
                tk_g[lt * 4 + 0] = inv; tk_g[lt * 4 + 1] = e1 * inv; tk_g[lt * 4 + 2] = e2 * inv; tk_g[lt * 4 + 3] = e3 * inv;
            }
        }
        __syncthreads();
        const int mybin = tk_e[tid] * 4 + (tid & 3);
        tk_r[tid] = __hip_atomic_fetch_add(&lcnt[mybin], 1, __ATOMIC_RELAXED, __HIP_MEMORY_SCOPE_WORKGROUP);
        __syncthreads();
        if (tid < NBIN) { const int c = lcnt[tid]; lbase[tid] = c ? (int)atomicAdd(&gcnt[tid], (unsigned)c) : 0; lcnt[tid] = 0; }
        __syncthreads();
        { const int pos = lbase[mybin] + tk_r[tid]; const size_t idx = (size_t)mybin * CAP + pos; ent_tok[idx] = ch * 128 + (tid >> 2); ent_gate[idx] = tk_g[tid]; ent_gate[(size_t)NBIN * CAP + idx] = tk_s[tid >> 2]; tokpos[ch * 512 + tid] = (mybin << 16) | pos; }
        __syncthreads();
    }
}

__device__ __forceinline__ void p7_combine(Frame& F) {
    const int gw = F.vcu * NWAVES + F.wave, NGW = F.G * NWAVES, lane = F.lane;
    const int* tokpos = (const int*)(F.ws + WS_TP); const unsigned char* Y = F.ws + WS_Y; const bf16_t* x1b = (const bf16_t*)(F.ws + WS_X1B);
    for (int t = gw; t < MTOK; t += NGW) {
        const int4 tp = *(const int4*)(tokpos + 4 * t);
        const int tpv[4] = {tp.x, tp.y, tp.z, tp.w};
        size_t row[4];
#pragma unroll
        for (int k = 0; k < 4; ++k) { const int bin = tpv[k] >> 16, pos = tpv[k] & 0xffff, e = bin >> 2; row[k] = (size_t)(F.MS[MS_BASE + e] + F.MS[MS_CUM + bin] + pos); }
        u32x2 xb[4]; unsigned y[4][4];
#pragma unroll
        for (int j = 0; j < 4; ++j) xb[j] = __builtin_nontemporal_load((const u32x2*)(x1b + (size_t)t * DMODEL) + lane + 64 * j);
#pragma unroll
        for (int k = 0; k < 4; ++k)
#pragma unroll
            for (int j = 0; j < 4; ++j) y[k][j] = __builtin_nontemporal_load((const unsigned*)(Y + row[k] * DMODEL) + lane + 64 * j);
        f32x4* op = (f32x4*)(F.out + (size_t)t * DMODEL) + lane;
#pragma unroll
        for (int j = 0; j < 4; ++j) {
            f32x4 v = (f32x4){bf_lo(xb[j].x), bf_hi(xb[j].x), bf_lo(xb[j].y), bf_hi(xb[j].y)};
#pragma unroll
            for (int k = 0; k < 4; ++k) { const f32x2 lo = __builtin_amdgcn_cvt_pk_f32_fp8((int)y[k][j], false), hi = __builtin_amdgcn_cvt_pk_f32_fp8((int)y[k][j], true); v += (f32x4){lo.x, lo.y, hi.x, hi.y}; }
            __builtin_nontemporal_store(v, op + 64 * j);
        }
    }
}

__device__ __forceinline__ void moe_setup(Frame& F, int mode) {
    const unsigned* gcnt = (const unsigned*)(F.ws + WS_CTL);
    __syncthreads();
    if (F.tid < 64) {
        const int e = F.tid & 31;
        const int c0 = (int)__hip_atomic_load(gcnt + 4 * e, RLX_AGENT), c1 = (int)__hip_atomic_load(gcnt + 4 * e + 1, RLX_AGENT), c2 = (int)__hip_atomic_load(gcnt + 4 * e + 2, RLX_AGENT), c3 = (int)__hip_atomic_load(gcnt + 4 * e + 3, RLX_AGENT);
        const int ne = c0 + c1 + c2 + c3;
        const int nsel = mode < 0 ? ne : (mode == 0 ? c0 : mode == 1 ? c1 : mode == 2 ? c2 : c3);
        const int nt = (nsel + 255) >> 8;
        int sb = ne, st = nt;
#pragma unroll
        for (int o = 1; o < 32; o <<= 1) { const int tb = __shfl_up(sb, o, 32), tt = __shfl_up(st, o, 32); if (e >= o) { sb += tb; st += tt; } }
        if (F.tid < 32) {
            F.MS[MS_CNT + 4 * e] = c0; F.MS[MS_CNT + 4 * e + 1] = c1; F.MS[MS_CNT + 4 * e + 2] = c2; F.MS[MS_CNT + 4 * e + 3] = c3;
            F.MS[MS_CUM + 4 * e] = 0; F.MS[MS_CUM + 4 * e + 1] = c0; F.MS[MS_CUM + 4 * e + 2] = c0 + c1; F.MS[MS_CUM + 4 * e + 3] = c0 + c1 + c2; F.MS[MS_NE + e] = ne;
            F.MS[MS_ADJ + 4 * e] = (4 * e) * CAP; F.MS[MS_ADJ + 4 * e + 1] = (4 * e + 1) * CAP - c0; F.MS[MS_ADJ + 4 * e + 2] = (4 * e + 2) * CAP - (c0 + c1); F.MS[MS_ADJ + 4 * e + 3] = (4 * e + 3) * CAP - (c0 + c1 + c2);
            F.MS[MS_BASE + e] = sb - ne; F.MS[MS_TILE + e] = st - nt;
            if (e == NEXP - 1) { F.MS[MS_BASE + NEXP] = sb; F.MS[MS_TILE + NEXP] = st; }
            for (int rt = st - nt; rt < st; ++rt) F.MS[MS_TEXP + rt] = e;
        }
    }
    __syncthreads();
}

struct Args { const float* in[22]; float* out; unsigned char* ws; int ph_lo, ph_hi, coop, pad; };
constexpr int NPHASE = 8;
#ifndef PHM
#define PHM 0xff
#endif
#define PHON(k) (((PHM) >> (k)) & 1)
#ifndef REP_PH
#define REP_PH -1
#endif
#define REPEAT(k) for (int rep_ = 0; rep_ < ((REP_PH) == (k) ? 2 : 1); ++rep_)

__global__ void __launch_bounds__(NTHR, 2) hymba_fwd(Args args) {
    __builtin_assume(__builtin_amdgcn_workitem_id_y() == 0); __builtin_assume(__builtin_amdgcn_workitem_id_z() == 0);
    extern __shared__ __attribute__((aligned(16))) unsigned char lds[];
    Frame F;
    F.lds = (LAS unsigned char*)lds; F.MS = (LAS int*)(F.lds + MISC_OFF);
    F.tid = threadIdx.x; F.lane = F.tid & 63; F.wave = __builtin_amdgcn_readfirstlane(F.tid >> 6);
    F.G = gridDim.x; { const int bx = blockIdx.x; F.vcu = (F.G % 8 == 0) ? (bx % 8) * (F.G / 8) + bx / 8 : bx; }
    F.ws = args.ws; F.out = args.out;
#pragma unroll
    for (int i = 0; i < 22; ++i) F.in[i] = args.in[i];
    const int lo = args.ph_lo, hi = args.ph_hi;
    XcdBarrier bar; bar.bar = nullptr; bar.x = 0; bar.st = nullptr;
    if (args.coop) {
        if (F.tid < 2) F.MS[MS_BARST + F.tid] = 0;
        __syncthreads();
        bar = xcd_barrier_post((unsigned*)(F.ws + WS_CTL) + CW_BAR, (volatile LAS unsigned*)(F.MS + MS_BARST));
    }
#define FRESH() do { int t_ = threadIdx.x; asm volatile("" : "+v"(t_)); F.tid = t_; F.lane = t_ & 63; } while (0)
#define IN(k) (lo <= (k) && (k) < hi)
#ifndef USE_CG_SYNC0
#define USE_CG_SYNC0 0
#endif
#define SEAM(k) do { if (IN(k) && IN((k) + 1) && args.coop) { if (USE_CG_SYNC0 && (k) == 0) cg::this_grid().sync(); else xcd_barrier(bar); } } while (0)

    REPEAT(0) { if ((REP_PH) == 0 && rep_ == 1) xcd_barrier(bar); FRESH(); if (PHON(0) && IN(0)) p0_prologue(F); }
    SEAM(0);
    REPEAT(1) { if ((REP_PH) == 1 && rep_ == 1) xcd_barrier(bar);
      FRESH(); if (PHON(1) && IN(1)) {
        pg8::DenseOrder S; S.init(F.ws + WS_WIN, MTOK, NPROJ, F.G, (int)blockIdx.x);
        { LAS float* tb = (LAS float*)(F.lds + EPM_OFF);
          if (F.tid < 256) tb[F.tid] = ((const float*)(F.ws + WS_GN))[F.tid]; else if (F.tid < 320) tb[F.tid] = ((const float*)(F.ws + WS_TAB))[F.tid - 256];
          __syncthreads(); }
        EpiInProj E{F.ws, (const LAS float*)(F.lds + EPM_OFF)};
        pg8::gemm_phase<false>(F.lds, (const char*)(F.ws + WS_XN), S, E);
    } }
    SEAM(1);
    REPEAT(2) { if ((REP_PH) == 2 && rep_ == 1) xcd_barrier(bar); FRESH(); if (PHON(2) && IN(2)) p2_attention(F, (char*)lds); }
    SEAM(2);
    REPEAT(3) { if ((REP_PH) == 3 && rep_ == 1) xcd_barrier(bar);
      FRESH(); if (PHON(3) && IN(3)) {
        pg8::DenseOrder S; S.init(F.ws + WS_WOUT, MTOK, DMODEL, F.G, (int)blockIdx.x);
        EpiOutProj E{(const bf16_t*)(F.ws + WS_XN), (const float*)(F.ws + WS_SIG), (bf16_t*)(F.ws + WS_X1B), F.ws + WS_X18};
        pg8::gemm_phase<false>(F.lds, (const char*)(F.ws + WS_CAT), S, E);
        if (PHON(4) && IN(4)) p4_fill(F);
    } }
    SEAM(3);
    FRESH(); if (PHON(4) && IN(4)) p4_route(F, PHON(3) && IN(3));
    SEAM(4);
    REPEAT(5) { if ((REP_PH) == 5 && rep_ == 1) xcd_barrier(bar);
      FRESH(); if (PHON(5) && IN(5)) {
        moe_setup(F, -1);
        MoeUpOrder S{F.MS, F.ws, (const char*)(F.ws + WS_WGU), F.G, F.vcu};
        EpiSwiglu E{F.MS, F.ws, F.in[I_BG], F.in[I_BU], F.ws + WS_MID};
        pg8::gemm_phase<true>(F.lds, (const char*)(F.ws + WS_X18), S, E);
    } }
    SEAM(5);
    REPEAT(6) { if ((REP_PH) == 6 && rep_ == 1) xcd_barrier(bar);
      FRESH(); if (PHON(6) && IN(6)) {
        if (!IN(5)) moe_setup(F, -1);
        MoeDownOrder S{F.MS, (const char*)(F.ws + WS_WD), F.G, F.vcu};
        EpiDownY E{F.MS, F.ws, F.in[I_BD], F.ws + WS_Y};
        pg8::gemm_phase<true>(F.lds, (const char*)(F.ws + WS_MID), S, E);
    } }
    SEAM(6);
    FRESH(); if (PHON(7) && IN(7)) { if (!IN(5) && !IN(6)) moe_setup(F, -1); p7_combine(F); }
#undef IN
#undef SEAM
}

#ifndef N_LAUNCH_MODE
#define N_LAUNCH_MODE 1
#endif
extern "C" void kernel_launch(void* const* d_in, const int* in_sizes, int n_in, void* d_out, int out_size, void* d_ws, size_t ws_size, hipStream_t stream) {
    static int grid = 0;
    if (grid == 0) {
        if (n_in != 22 || out_size != MTOK * DMODEL || ws_size < WS_END) { fprintf(stderr, "kernel_launch: unexpected shapes (n_in %d out %d ws %zu)\n", n_in, out_size, ws_size); grid = -1; return; }
        int dev = 0, cus = 0, per_cu = 0;
        hipGetDevice(&dev); hipDeviceGetAttribute(&cus, hipDeviceAttributeMultiprocessorCount, dev);
        hipFuncSetAttribute((const void*)hymba_fwd, hipFuncAttributeMaxDynamicSharedMemorySize, LDS_BYTES);
        hipOccupancyMaxActiveBlocksPerMultiprocessor(&per_cu, (const void*)hymba_fwd, NTHR, LDS_BYTES);
        if (per_cu < 1) { fprintf(stderr, "kernel_launch: occupancy query says %d blocks/CU\n", per_cu); per_cu = 1; }
        (void)hipGetLastError();
        grid = cus < 256 ? cus : 256;
    }
    if (grid < 0) return;
    (void)hipMemsetAsync((char*)d_ws + WS_CTL, 0, CTL_ZERO_BYTES, stream);
    Args a{};
    for (int i = 0; i < 22; ++i) a.in[i] = (const float*)d_in[i];
    a.out = (float*)d_out; a.ws = (unsigned char*)d_ws;
#if N_LAUNCH_MODE == 1
    a.ph_lo = 0; a.ph_hi = NPHASE; a.coop = 1;
    void* kargs[] = {&a};
    hipError_t e = hipLaunchCooperativeKernel((const void*)hymba_fwd, dim3(grid), dim3(NTHR), kargs, LDS_BYTES, stream);
    if (e != hipSuccess) fprintf(stderr, "cooperative launch failed: %s (grid %d)\n", hipGetErrorString(e), grid);
#else
    for (int p = 0; p < NPHASE; ++p) {
        a.ph_lo = p; a.ph_hi = p + 1; a.coop = 0;
        hipLaunchKernelGGL(hymba_fwd, dim3(grid), dim3(NTHR), LDS_BYTES, stream, a);
    }
#endif
}
```

```cpp
#include <hip/hip_runtime.h>
#include <hip/hip_bf16.h>
#include <hip/hip_cooperative_groups.h>
#include <cstdio>
#include <cstdint>
#include <cmath>
namespace cg = cooperative_groups;

#define LAS __attribute__((address_space(3)))
#define GAS __attribute__((address_space(1)))
typedef unsigned short bf16_t;
typedef short bf16x8 __attribute__((ext_vector_type(8)));
typedef float f32x4 __attribute__((ext_vector_type(4)));
typedef float f32x2 __attribute__((ext_vector_type(2)));
typedef unsigned u32x4 __attribute__((ext_vector_type(4)));
typedef unsigned u32x2 __attribute__((ext_vector_type(2)));

constexpr int BATCH = 8, SEQ = 4096, DMODEL = 1024, MTOK = BATCH * SEQ;
constexpr int NPROJ = 2304, KDIM = 1024;
constexpr int NEXP = 32, TOPK = 4, DEXP = 1024, NBIN = NEXP * TOPK, CAP = MTOK;
constexpr float EPS = 1e-6f;
constexpr float C2 = 0.125f * 1.4426950408889634f;
constexpr float LAM_INIT = 0.2f;
constexpr int NWAVES = 8, NTHR = 512;

constexpr size_t MiB = 1u << 20;
constexpr size_t WS_CTL = 0;
constexpr int CW_BAR = 1024; constexpr size_t CTL_ZERO_BYTES = 65536;
constexpr size_t WS_TAB = 1 * MiB;
constexpr size_t WS_WR = 3 * MiB;
constexpr size_t WS_RSTD = 3 * MiB + 128 * 1024;
constexpr size_t WS_GN = 3 * MiB + 256 * 1024;
constexpr size_t WS_WIN = 4 * MiB;
constexpr size_t WS_WOUT = 9 * MiB;
constexpr float CAT_SA = 4.0f, CAT_SB = 16.0f;
constexpr size_t WS_TP = 3 * MiB + 512 * 1024;
constexpr size_t WS_WD = 11 * MiB;
constexpr size_t WS_ENT = 43 * MiB;
constexpr size_t WS_MID = 91 * MiB;
constexpr size_t WS_XN = WS_MID, WS_CAT = WS_MID + 64 * MiB;
constexpr size_t WS_OAP = 459 * MiB;
constexpr size_t WS_SIG = 2 * MiB;
constexpr size_t WS_Y = 219 * MiB;
constexpr size_t WS_X1B = 347 * MiB;
constexpr size_t WS_WGU = WS_Y;
constexpr size_t WS_X18 = WS_Y + 64 * MiB;
constexpr size_t WS_QA = WS_Y + 96 * MiB, WS_KA = WS_QA + 32 * MiB, WS_VA = WS_QA + 64 * MiB, WS_QB = WS_QA + 96 * MiB, WS_KB = WS_QA + 128 * MiB, WS_VB = WS_QA + 136 * MiB;
constexpr size_t WS_END = 523 * MiB;

constexpr int RING_BYTES = 131072, MISC_OFF = RING_BYTES, LDS_BYTES = 147456;
constexpr int MS_CNT = 0, MS_NE = 128, MS_BASE = 160, MS_TILE = 200, MS_CUM = 256, MS_ADJ = 384;
constexpr int MS_TEXP = 512;
constexpr int EPM_OFF = 131072 + 12288;
constexpr int MS_BARST = 2048;

#define RLX_AGENT __ATOMIC_RELAXED, __HIP_MEMORY_SCOPE_AGENT
__device__ __forceinline__ unsigned cvt_pk_bf16(float lo, float hi) { unsigned r; asm volatile("v_cvt_pk_bf16_f32 %0, %1, %2" : "=v"(r) : "v"(lo), "v"(hi)); return r; }
__device__ __forceinline__ float clamp448(float v) { return __builtin_amdgcn_fmed3f(v, -448.0f, 448.0f); }
__device__ __forceinline__ unsigned pk4_fp8(float a, float b, float c, float d) {
    int w = 0; w = __builtin_amdgcn_cvt_pk_fp8_f32(clamp448(a), clamp448(b), w, false); w = __builtin_amdgcn_cvt_pk_fp8_f32(clamp448(c), clamp448(d), w, true); return (unsigned)w; }
__device__ __forceinline__ float bf_lo(unsigned w) { return __uint_as_float(w << 16); }
__device__ __forceinline__ float bf_hi(unsigned w) { return __uint_as_float(w & 0xffff0000u); }
template <int CTRL> __device__ __forceinline__ float dppf(float v) { return __int_as_float(__builtin_amdgcn_update_dpp(0, __float_as_int(v), CTRL, 0xf, 0xf, false)); }
template <int CTRL> __device__ __forceinline__ int dppi(int v) { return __builtin_amdgcn_update_dpp(0, v, CTRL, 0xf, 0xf, false); }
__device__ __forceinline__ float xor1f(float v) { return dppf<0xB1>(v); }
__device__ __forceinline__ float xor2f(float v) { return dppf<0x4E>(v); }
__device__ __forceinline__ float xor4f(float v) { return dppf<0x1B>(dppf<0x141>(v)); }
__device__ __forceinline__ float xor8f(float v) { return dppf<0x128>(v); }
__device__ __forceinline__ int xor2i(int v) { return dppi<0x4E>(v); }
__device__ __forceinline__ int xor4i(int v) { return dppi<0x1B>(dppi<0x141>(v)); }
__device__ __forceinline__ int xor8i(int v) { return dppi<0x128>(v); }
__device__ __forceinline__ float xor16f(float v, int lane) { const auto r = __builtin_amdgcn_permlane16_swap(__float_as_uint(v), __float_as_uint(v), false, false); return __uint_as_float((lane & 16) ? r[0] : r[1]); }
__device__ __forceinline__ float xor32f(float v, int lane) { const auto r = __builtin_amdgcn_permlane32_swap(__float_as_uint(v), __float_as_uint(v), false, false); return __uint_as_float((lane & 32) ? r[0] : r[1]); }
__device__ __forceinline__ int xor16i(int v, int lane) { const auto r = __builtin_amdgcn_permlane16_swap((unsigned)v, (unsigned)v, false, false); return (int)((lane & 16) ? r[0] : r[1]); }
__device__ __forceinline__ int xor32i(int v, int lane) { const auto r = __builtin_amdgcn_permlane32_swap((unsigned)v, (unsigned)v, false, false); return (int)((lane & 32) ? r[0] : r[1]); }
__device__ __forceinline__ float sum16f(float v) { const auto r = __builtin_amdgcn_permlane16_swap(__float_as_uint(v), __float_as_uint(v), false, false); return __uint_as_float(r[0]) + __uint_as_float(r[1]); }
__device__ __forceinline__ float sum32f(float v) { const auto r = __builtin_amdgcn_permlane32_swap(__float_as_uint(v), __float_as_uint(v), false, false); return __uint_as_float(r[0]) + __uint_as_float(r[1]); }
__device__ __forceinline__ float wave_sum(float v) {
#pragma unroll
    for (int o = 1; o < 64; o <<= 1) v += __shfl_xor(v, o);
    return v;
}


#define XB_TMO      128
#define XB_XCNT(j)  (256  + 64 * (j))
#define XB_XSUB(j)  (1280 + 64 * (j))
#define XB_XGEN(j)  (2304 + 64 * (j))
#define XB_TOP      3328
#define XB_TOPGEN   3392
#define XCD_BAR_WORDS 3456
#define XB_SPIN_CAP (1u << 22)
__device__ __forceinline__ unsigned xb_ld(unsigned* p)              { return __hip_atomic_load(p, __ATOMIC_RELAXED, __HIP_MEMORY_SCOPE_AGENT); }
__device__ __forceinline__ unsigned xb_add(unsigned* p, unsigned v) { return __hip_atomic_fetch_add(p, v, __ATOMIC_RELAXED, __HIP_MEMORY_SCOPE_AGENT); }
__device__ __forceinline__ unsigned xb_xcc_id() { return (unsigned)__builtin_amdgcn_s_getreg((3 << 11) | 20) & 0xFu; }
#define XB_SPIN(cond, bar) do { unsigned _sp = 0; while (cond) { __builtin_amdgcn_s_sleep(1); \
    if ((++_sp & 255u) == 0u) { if (xb_ld(&(bar)[XB_TMO])) break; if (_sp > XB_SPIN_CAP) { atomicAdd(&(bar)[XB_TMO], 1u); break; } } } } while (0)
struct XcdBarrier { unsigned* bar; unsigned x; volatile LAS unsigned* st; };
__device__ __forceinline__ XcdBarrier xcd_barrier_post(unsigned* bar, volatile LAS unsigned* st) {
    XcdBarrier b; b.bar = bar; b.x = xb_xcc_id(); b.st = st;
    if (threadIdx.x == 0) (void)xb_add(&bar[XB_XCNT(b.x)], 1u);
    return b;
}
__device__ __forceinline__ void xcd_barrier_complete(unsigned* bar, unsigned x, unsigned& nloc, unsigned& nx) {
    const unsigned G = gridDim.x * gridDim.y * gridDim.z;
    unsigned sum, cnt, mine, sp = 0u;
    for (;;) {
        sum = 0u; cnt = 0u; mine = 0u;
#pragma unroll
        for (unsigned j = 0; j < 16; ++j) { const unsigned c = xb_ld(&bar[XB_XCNT(j)]); sum += c; cnt += (c > 0u) ? 1u : 0u; mine = (j == x) ? c : mine; }
        if (sum == G) break;
        __builtin_amdgcn_s_sleep(1);
        if ((++sp & 255u) == 0u) { if (xb_ld(&bar[XB_TMO])) break; if (sp > XB_SPIN_CAP) { atomicAdd(&bar[XB_TMO], 1u); break; } }
    }
    nloc = mine > 0u ? mine : 1u; nx = cnt > 0u ? cnt : 1u;
}
__device__ __forceinline__ void xcd_barrier(const XcdBarrier& b) {
    asm volatile("s_waitcnt vmcnt(0)" ::: "memory");
    __syncthreads();
    if (threadIdx.x == 0) {
        unsigned* bar = b.bar;
        __builtin_amdgcn_s_waitcnt(0);
        unsigned nloc = b.st[0], nx = b.st[1];
        if (nloc == 0u) { xcd_barrier_complete(bar, b.x, nloc, nx); b.st[0] = nloc; b.st[1] = nx; }
        const unsigned old = xb_add(&bar[XB_XSUB(b.x)], 1u);
        const unsigned gen = old / nloc;
        if (old + 1u == (gen + 1u) * nloc) {
            __builtin_amdgcn_fence(__ATOMIC_RELEASE, "agent");
            asm volatile("s_waitcnt vmcnt(0)" ::: "memory");
            const unsigned og = xb_add(&bar[XB_TOP], 1u);
            const unsigned tg = og / nx;
            __builtin_amdgcn_fence(__ATOMIC_ACQUIRE, "agent");
            if (og + 1u == (tg + 1u) * nx) xb_add(&bar[XB_TOPGEN], 1u);
            else XB_SPIN(xb_ld(&bar[XB_TOPGEN]) == tg, bar);
            xb_add(&bar[XB_XGEN(b.x)], 1u);
            asm volatile("s_waitcnt vmcnt(0)" ::: "memory");
        } else {
            __builtin_amdgcn_fence(__ATOMIC_ACQUIRE, "agent");
            XB_SPIN(xb_ld(&bar[XB_XGEN(b.x)]) == gen, bar);
            asm volatile("s_waitcnt vmcnt(0)" ::: "memory");
        }
    }
    __syncthreads();
}

namespace pg8 {
constexpr int BM = 256, BK = 64, HALF = 128, HTB = HALF * BK * 2, STAGE_BYTES = 8 * HTB, NXCD = 8, WGM = 8, K = KDIM;
template <bool FP8> __host__ __device__ __forceinline__ int lds_byte(int r, int col) {
    const int c = col >> 3, low = FP8 ? ((c >> 1) & 1) : (c & 1), mid = FP8 ? (c & 1) : ((c >> 1) & 1);
    return (r >> 3) * 1024 + 16 * (16 * (2 * (c >> 2) + mid) + 2 * (r & 7) + low);
}
template <bool FP8> __host__ __device__ __forceinline__ void stage_rc(int b, int& R, int& C) {
    const int blk = b >> 10, p = (b & 1023) >> 4, r7 = (p & 15) >> 1, low = p & 1, A = p >> 5, B = (p >> 4) & 1;
    const int c = FP8 ? (4 * A + 2 * low + B) : (4 * A + 2 * B + low);
    R = 8 * blk + r7; C = 8 * c;
}
__host__ __device__ __forceinline__ int perm32(int rho) { const int n = rho >> 4, i = rho & 15; return 8 * (i >> 2) + 4 * n + (i & 3); }

struct Unit { int pm, pn, e, r0, nrows; };


typedef int v8i __attribute__((ext_vector_type(8)));
typedef int v4i __attribute__((ext_vector_type(4)));
template <bool FP8, class Epi, class Sched>
__device__ __forceinline__ void gemm_phase(LAS unsigned char* lds, const char* gA, const Sched& S, const Epi& E) {
    int tid_ = threadIdx.x; asm volatile("" : "+v"(tid_));
    const int tid = tid_, wid = __builtin_amdgcn_readfirstlane(tid >> 6), lane = tid & 63, wr = wid >> 2, wc = wid & 3, fr = lane & 15, fq = lane >> 4;
    constexpr int RP = FP8 ? K : 2 * K;
    constexpr int nt = RP / 128;
    constexpr int KUNR = nt / 2;
    int Rs[2], Cs[2]; unsigned voffB[2];
#pragma unroll
    for (int i = 0; i < 2; ++i) { int R, C; stage_rc<FP8>(tid * 16 + i * 8192, R, C);
        const int Rb = Epi::PERM16 ? (64 * (R >> 5) + 16 * ((R & 15) >> 2) + 4 * ((R >> 4) & 1) + (R & 3)) : ((R & ~31) + perm32(R & 31));
        Rs[i] = R; Cs[i] = C; voffB[i] = (unsigned)(Rb * RP + C * 2); }
    const size_t kstep = (size_t)(BK * 2);
    const size_t hstep = (size_t)(Epi::PERM16 ? 8 : HALF) * RP;
    unsigned voffBh[2];
#pragma unroll
    for (int i = 0; i < 2; ++i) voffBh[i] = voffB[i] + (unsigned)hstep;
    const unsigned ldsw = (unsigned)wid * 1024u;
    const int aoff = lds_byte<FP8>(wr * 64 + fr, FP8 ? fq * 16 : fq * 8), boff = lds_byte<FP8>(wc * 32 + fr, FP8 ? fq * 16 : fq * 8);
    const int scl = 0x7f7f7f7f;
#define PG8_SA(b, h) (((b) * 2 + (h)) * HTB)
#define PG8_SB(b, h) ((4 + (b) * 2 + (h)) * HTB)
#define PG8_STAGE(bufoff, gbase, voff) do { const char* gb_ = (const char*)(gbase); asm volatile("" : "+s"(gb_));     \
        _Pragma("unroll") for (int _i = 0; _i < 2; ++_i) \
        __builtin_amdgcn_global_load_lds((const unsigned*)(gb_ + (voff)[_i]), (LAS unsigned*)(lds + (bufoff) + ldsw + _i * 8192), 16, 0, 0); } while (0)
#define PG8_LDA(dst, b, h) do { _Pragma("unroll") for (int m = 0; m < 4; ++m) { \
        if constexpr (FP8) { dst##8[m].lo = *(const LAS v4i*)(lds + PG8_SA(b, h) + aoff + m * 2048); dst##8[m].hi = *(const LAS v4i*)(lds + PG8_SA(b, h) + aoff + m * 2048 + 256); } \
        else { _Pragma("unroll") for (int k = 0; k < 2; ++k) dst[m][k] = *(const LAS bf16x8*)(lds + PG8_SA(b, h) + aoff + m * 2048 + k * 512); } } } while (0)
#define PG8_LDB(dst, b, h) do { _Pragma("unroll") for (int n = 0; n < 2; ++n) { \
        if constexpr (FP8) { dst##8[n].lo = *(const LAS v4i*)(lds + PG8_SB(b, h) + boff + n * 2048); dst##8[n].hi = *(const LAS v4i*)(lds + PG8_SB(b, h) + boff + n * 2048 + 256); } \
        else { _Pragma("unroll") for (int k = 0; k < 2; ++k) dst[n][k] = *(const LAS bf16x8*)(lds + PG8_SB(b, h) + boff + n * 2048 + k * 512); } } } while (0)
#define PG8_ACC(ai, bj, m, n) ((n) == 0 ? acc8[ai][bj][m].lo : acc8[ai][bj][m].hi)
#define PG8_MMA(ai, bj, At, Bt) do { if constexpr (!FP8) __builtin_amdgcn_s_setprio(1); _Pragma("unroll") for (int m = 0; m < 4; ++m) { \
        if constexpr (FP8) { f32x4 lo_ = acc8[ai][bj][m].lo, hi_ = acc8[ai][bj][m].hi; \
                             if (m == 0) asm volatile("s_nop 1\n\tv_mfma_f32_16x16x128_f8f6f4 %0, %1, %2, %0" : "+v"(lo_) : "v"(Bt##8[0]), "v"(At##8[m])); \
                             else        asm volatile("v_mfma_f32_16x16x128_f8f6f4 %0, %1, %2, %0" : "+v"(lo_) : "v"(Bt##8[0]), "v"(At##8[m])); \
                             asm volatile("v_mfma_f32_16x16x128_f8f6f4 %0, %1, %2, %0" : "+v"(hi_) : "v"(Bt##8[1]), "v"(At##8[m])); \
                             acc8[ai][bj][m].lo = lo_; acc8[ai][bj][m].hi = hi_; } \
        else { _Pragma("unroll") for (int k = 0; k < 2; ++k) { acc8[ai][bj][m].lo = __builtin_amdgcn_mfma_f32_16x16x32_bf16(Bt[0][k], At[m][k], acc8[ai][bj][m].lo, 0, 0, 0); \
                                                                acc8[ai][bj][m].hi = __builtin_amdgcn_mfma_f32_16x16x32_bf16(Bt[1][k], At[m][k], acc8[ai][bj][m].hi, 0, 0, 0); } } } \
        if constexpr (!FP8) __builtin_amdgcn_s_setprio(0); } while (0)
#define PG8_ZERO(ai) do { _Pragma("unroll") for (int b_ = 0; b_ < 2; ++b_) { _Pragma("unroll") for (int m_ = 0; m_ < 4; ++m_) acc8[ai][b_][m_] = (f32x8){0.f, 0.f, 0.f, 0.f, 0.f, 0.f, 0.f, 0.f}; } } while (0)
#define PG8_WAIT_V(n) asm volatile("s_waitcnt vmcnt(" #n ")" ::: "memory")
#define PG8_WAIT_L(n) asm volatile("s_waitcnt lgkmcnt(" #n ")" ::: "memory")
#define PG8_BAR __builtin_amdgcn_s_barrier()
#define PG8_SCHED __builtin_amdgcn_sched_barrier(0)
    Unit cur, nxt; int ui = 0;
    if (!S.next(0, cur)) return;
    typedef float f32x8 __attribute__((ext_vector_type(8)));
    f32x8 acc8[2][2][4];
#pragma unroll
    for (int a = 0; a < 2; ++a)
#pragma unroll
        for (int b = 0; b < 2; ++b)
#pragma unroll
            for (int m = 0; m < 4; ++m) acc8[a][b][m] = (f32x8){0.f, 0.f, 0.f, 0.f, 0.f, 0.f, 0.f, 0.f};
    bf16x8 At[4][2], B0[2][2], B1[2][2]; v8i At8[4], B08[2], B18[2];
    unsigned aoc[2][2], aon[2][2];
#pragma unroll
    for (int h = 0; h < 2; ++h)
#pragma unroll
        for (int i = 0; i < 2; ++i) aoc[h][i] = S.arow(cur, h * HALF + Rs[i]) + (unsigned)Cs[i] * 2u;
    const char* cB = S.bbase(cur);
    PG8_STAGE(PG8_SB(0, 0), cB, voffB); PG8_STAGE(PG8_SB(0, 1), cB, voffBh); PG8_STAGE(PG8_SA(0, 0), gA, aoc[0]); PG8_STAGE(PG8_SA(0, 1), gA, aoc[1]);
    if (wr == 1) PG8_BAR;
    PG8_WAIT_V(2); PG8_BAR;
    PG8_STAGE(PG8_SB(1, 0), cB + kstep, voffB); PG8_STAGE(PG8_SA(1, 0), gA + kstep, aoc[0]); PG8_STAGE(PG8_SB(1, 1), cB + kstep, voffBh);
    PG8_WAIT_V(6); PG8_BAR;
    for (;;) {
        const bool has_next = S.next(ui + 1, nxt);
        const char* nB = has_next ? S.bbase(nxt) : cB;
#pragma unroll
        for (int h = 0; h < 2; ++h)
#pragma unroll
            for (int i = 0; i < 2; ++i) aon[h][i] = has_next ? (S.arow(nxt, h * HALF + Rs[i]) + (unsigned)Cs[i] * 2u) : aoc[h][i];
#pragma unroll KUNR
        for (int t = 0; t < nt; t += 2) {
            const bool last = (t == nt - 2);
            asm volatile("" : "+v"(voffB[0]), "+v"(voffB[1]), "+v"(voffBh[0]), "+v"(voffBh[1]));
            if constexpr (Epi::PREDMA) { if (t == nt - 4) E.pre_dma(cur, tid, wid, lds + EPM_OFF); }
            const char* a1 = gA + (size_t)(t + 1) * kstep;
            const char* a2 = last ? gA : gA + (size_t)(t + 2) * kstep; const char* b2 = last ? nB : cB + (size_t)(t + 2) * kstep;
            const char* a3 = a2 + kstep; const char* b3 = b2 + kstep;
            unsigned o2[2][2];
            if (last) {
                asm volatile("" : "+v"(aon[0][0]), "+v"(aon[0][1]), "+v"(aon[1][0]), "+v"(aon[1][1]));
#pragma unroll
                for (int h = 0; h < 2; ++h)
#pragma unroll
                    for (int i = 0; i < 2; ++i) o2[h][i] = aon[h][i];
            } else {
#pragma unroll
                for (int h = 0; h < 2; ++h)
#pragma unroll
                    for (int i = 0; i < 2; ++i) o2[h][i] = aoc[h][i];
            }
            const bool zero_now = (t == 0) && (FP8 || ui > 0);
            PG8_LDB(B0, 0, 0); PG8_LDB(B1, 0, 1); PG8_SCHED; PG8_LDA(At, 0, 0); PG8_STAGE(PG8_SA(1, 1), a1, aoc[1]);
            if (zero_now) { PG8_ZERO(0); }
            PG8_WAIT_V(8); PG8_WAIT_L(0); PG8_BAR; PG8_MMA(0, 0, At, B0); PG8_MMA(0, 1, At, B1); PG8_BAR; PG8_SCHED;
            PG8_LDA(At, 0, 1); PG8_STAGE(PG8_SB(0, 0), b2, voffB); PG8_STAGE(PG8_SB(0, 1), b2, voffBh); PG8_STAGE(PG8_SA(0, 0), a2, o2[0]);
            if (zero_now) { PG8_ZERO(1); }
            PG8_WAIT_V(8); PG8_WAIT_L(0); PG8_BAR; PG8_MMA(1, 0, At, B0); PG8_MMA(1, 1, At, B1); PG8_BAR; PG8_SCHED;
            PG8_LDB(B0, 1, 0); PG8_LDB(B1, 1, 1); PG8_SCHED; PG8_LDA(At, 1, 0); PG8_STAGE(PG8_SA(0, 1), a2, o2[1]);
            PG8_WAIT_V(8); PG8_WAIT_L(0); PG8_BAR; PG8_MMA(0, 0, At, B0); PG8_MMA(0, 1, At, B1); PG8_BAR; PG8_SCHED;
            PG8_LDA(At, 1, 1); PG8_STAGE(PG8_SB(1, 0), b3, voffB); PG8_STAGE(PG8_SB(1, 1), b3, voffBh); PG8_STAGE(PG8_SA(1, 0), a3, o2[0]);
            PG8_WAIT_V(8); PG8_WAIT_L(0); PG8_BAR; PG8_MMA(1, 0, At, B0); PG8_MMA(1, 1, At, B1); PG8_BAR; PG8_SCHED;
        }
        if constexpr (FP8) asm volatile("s_nop 15\n\ts_nop 7" ::: "memory");
        if (wr == 0) PG8_BAR;
        { int fr_ = fr, fq_ = fq; asm volatile("" : "+v"(fr_), "+v"(fq_));
          f32x4 acc[2][2][4][2];
#pragma unroll
          for (int a = 0; a < 2; ++a)
#pragma unroll
              for (int b = 0; b < 2; ++b)
#pragma unroll
                  for (int m = 0; m < 4; ++m) { acc[a][b][m][0] = acc8[a][b][m].lo; acc[a][b][m][1] = acc8[a][b][m].hi; }
          E(acc, cur, wr, wc, fr_, fq_); }
        if (!has_next) break;
        cur = nxt; cB = nB; ++ui;
#pragma unroll
        for (int h = 0; h < 2; ++h)
#pragma unroll
            for (int i = 0; i < 2; ++i) aoc[h][i] = aon[h][i];
        if (wr == 1) PG8_BAR;
    }
    PG8_WAIT_V(0);
    PG8_BAR;
#undef PG8_SA
#undef PG8_SB
#undef PG8_STAGE
#undef PG8_LDA
#undef PG8_LDB
#undef PG8_MMA
#undef PG8_ZERO
#undef PG8_WAIT_V
#undef PG8_WAIT_L
#undef PG8_BAR
#undef PG8_SCHED
}

struct DenseOrder {
    const char* Bt; int nM, nN, nwg, G, c, esz;
    __device__ void init(const void* Bt_, int M, int N, int G_, int c_, int esz_ = 2) { Bt = (const char*)Bt_; nM = M / BM; nN = N / BM; nwg = nM * nN; G = G_; c = c_; esz = esz_; }
    __device__ __forceinline__ bool next(int i, Unit& u) const {
        const long L = (long)i * G + c; if (L >= nwg) return false;
        int wgid = (int)L; { const int q = nwg / NXCD, r = nwg % NXCD, xcd = wgid % NXCD, off = wgid / NXCD; wgid = (xcd < r ? xcd * (q + 1) : r * (q + 1) + (xcd - r) * q) + off; }
        const int nig = WGM * nN, gid = wgid / nig, fm = gid * WGM, gsz = (nM - fm) < WGM ? (nM - fm) : WGM;
        u.pm = fm + ((wgid % nig) % gsz); u.pn = (wgid % nig) / gsz; u.e = 0; u.r0 = 0; u.nrows = BM; return true;
    }
    __device__ __forceinline__ const char* bbase(const Unit& u) const { return Bt + (size_t)u.pn * BM * K * esz; }
    __device__ __forceinline__ unsigned arow(const Unit& u, int r) const { return (unsigned)(u.pm * BM + r) * (unsigned)(K * esz); }
};
}

struct Frame {
    LAS unsigned char* lds; LAS int* MS;
    int tid, lane, wave, vcu, G;
    unsigned char* ws; float* out;
    const float* in[22];
};
enum { I_X = 0, I_N1G, I_WIN, I_AQG, I_AKG, I_LQ1, I_LK1, I_LQ2, I_LK2, I_SUBG, I_BQG, I_BKG, I_WOUT, I_N2G, I_RW, I_RB, I_WG, I_BG, I_WU, I_BU, I_WDN, I_BD };

__device__ __forceinline__ size_t moe_idx(const LAS int* MS, int e, int m) {
    const LAS int* cum = MS + MS_CUM + 4 * e; const LAS int* adj = MS + MS_ADJ + 4 * e;
    const int c1 = cum[1], c2 = cum[2], c3 = cum[3];
    int a = adj[0]; a = (m >= c1) ? adj[1] : a; a = (m >= c2) ? adj[2] : a; a = (m >= c3) ? adj[3] : a;
    return (size_t)(unsigned)(m + a);
}
__device__ __forceinline__ int moe_tok(const LAS int* MS, const unsigned char* ws, int e, int m) { return ((const int*)(ws + WS_ENT))[moe_idx(MS, e, m)]; }
struct MoeUpOrder {
    const LAS int* MS; const unsigned char* ws; const char* Bt; int G, vcu;
    __device__ __forceinline__ bool next(int i, pg8::Unit& u) const {
        const LAS int* tp = MS + MS_TILE; const int total = tp[NEXP] * 8;
        const long L = (long)i * G + vcu; if (L >= total) return false;
        const int rt = (int)(L >> 3); u.pn = (int)(L & 7);
        const int e = MS[MS_TEXP + rt];
        u.e = e; u.pm = rt - tp[e]; u.r0 = u.pm * 256; const int ne = MS[MS_NE + e]; u.nrows = (ne - u.r0) < 256 ? (ne - u.r0) : 256; return true;
    }
    __device__ __forceinline__ const char* bbase(const pg8::Unit& u) const { return Bt + ((size_t)u.e * 2048 + (size_t)u.pn * 256) * KDIM; }
    __device__ __forceinline__ unsigned arow(const pg8::Unit& u, int r) const { const int rr = r < u.nrows ? r : u.nrows - 1; return (unsigned)moe_tok(MS, ws, u.e, u.r0 + rr) * (unsigned)KDIM; }
};
struct MoeDownOrder {
    const LAS int* MS; const char* Bt; int G, vcu;
    __device__ __forceinline__ bool next(int i, pg8::Unit& u) const {
        const LAS int* tp = MS + MS_TILE; const int total = tp[NEXP] * 4;
        const long L = (long)i * G + vcu; if (L >= total) return false;
        const int rt = (int)(L >> 2); u.pn = (int)(L & 3);
        const int e = MS[MS_TEXP + rt];
        u.e = e; u.pm = rt - tp[e]; u.r0 = u.pm * 256; const int ne = MS[MS_NE + e]; u.nrows = (ne - u.r0) < 256 ? (ne - u.r0) : 256; return true;
    }
    __device__ __forceinline__ const char* bbase(const pg8::Unit& u) const { return Bt + ((size_t)u.e * 1024 + (size_t)u.pn * 256) * KDIM; }
    __device__ __forceinline__ unsigned arow(const pg8::Unit& u, int r) const {
        const int rr = r < u.nrows ? r : u.nrows - 1;
        return (unsigned)(MS[MS_BASE + u.e] + u.r0 + rr) * (unsigned)KDIM;
    }
};

using pg8::Unit;
struct EpiInProj {
    static constexpr bool PERM16 = false; static constexpr bool PREDMA = false;
    unsigned char* ws; const LAS float* tabs;
    __device__ __forceinline__ void operator()(const f32x4 (&acc)[2][2][4][2], const Unit& u, int wr, int wc, int fr, int fq) const {
        int type, head; const int pn = u.pn;
        if (pn < 2) { type = 0; head = pn * 4 + wc; } else if (pn < 4) { type = 1; head = (pn - 2) * 4 + wc; } else if (pn < 6) { type = 2; head = (pn - 4) * 4 + wc; }
        else if (pn < 8) { type = 3; head = (pn - 6) * 4 + wc; } else if (wc < 2) { type = 4; head = wc; } else { type = 5; head = wc - 2; }
        bf16_t* dst = (bf16_t*)(ws + WS_QA + (size_t)(type <= 3 ? 32 * type : 128 + 8 * (type - 4)) * MiB);
        const int nheads = type <= 3 ? 8 : 2;
        const bool norm = (type != 2 && type != 5);
        const bool axial = type >= 3;
        const LAS float* gn = tabs + 64 * (type == 0 ? 0 : type == 1 ? 1 : type == 3 ? 2 : 3);
        const float scale = (type == 0 || type == 3) ? C2 : 1.0f;
        const int row0 = u.pm * 256 + wr * 64 + fr; const int b = row0 >> 12;
        dst += ((size_t)(b * nheads + head) * SEQ) * 64 + 8 * fq;
        f32x4 g0[2], g1[2], fr2[2];
        if (norm) {
            const LAS float* fqt = tabs + 256 + (axial ? 32 : 0);
#pragma unroll
            for (int n = 0; n < 2; ++n) { g0[n] = *(const LAS f32x4*)(gn + 8 * fq + 4 * n); g1[n] = *(const LAS f32x4*)(gn + 32 + 8 * fq + 4 * n); fr2[n] = *(const LAS f32x4*)(fqt + 8 * fq + 4 * n); }
        }
#pragma unroll
        for (int ai = 0; ai < 2; ++ai)
#pragma unroll
            for (int m = 0; m < 4; ++m) {
                const int s = (row0 + ai * 128 + m * 16) & (SEQ - 1);
                f32x4 v0[2], v1[2];
#pragma unroll
                for (int n = 0; n < 2; ++n) { v0[n] = acc[ai][0][m][n]; v1[n] = acc[ai][1][m][n]; }
                if (norm) {
                    float ss = 0.f;
#pragma unroll
                    for (int n = 0; n < 2; ++n)
#pragma unroll
                        for (int j = 0; j < 4; ++j) ss += v0[n][j] * v0[n][j] + v1[n][j] * v1[n][j];
                    ss += __shfl_xor(ss, 16); ss += __shfl_xor(ss, 32);
                    const float rstd = __builtin_amdgcn_rsqf(ss * (1.0f / 64.0f) + EPS);
                    const float pos = axial ? (float)((fq < 2) ? (s >> 6) : (s & 63)) : (float)s;
#pragma unroll
                    for (int n = 0; n < 2; ++n) {
                        f32x4 c, sn;
#pragma unroll
                        for (int j = 0; j < 4; ++j) { const float rev = __builtin_amdgcn_fractf(pos * fr2[n][j]); c[j] = __builtin_amdgcn_cosf(rev); sn[j] = __builtin_amdgcn_sinf(rev); }
                        const f32x4 y0 = v0[n] * rstd * g0[n], y1 = v1[n] * rstd * g1[n];
                        v0[n] = (y0 * c - y1 * sn) * scale; v1[n] = (y1 * c + y0 * sn) * scale;
                    }
                }
                u32x4 w0, w1;
                w0.x = cvt_pk_bf16(v0[0][0], v0[0][1]); w0.y = cvt_pk_bf16(v0[0][2], v0[0][3]); w0.z = cvt_pk_bf16(v0[1][0], v0[1][1]); w0.w = cvt_pk_bf16(v0[1][2], v0[1][3]);
                w1.x = cvt_pk_bf16(v1[0][0], v1[0][1]); w1.y = cvt_pk_bf16(v1[0][2], v1[0][3]); w1.z = cvt_pk_bf16(v1[1][0], v1[1][1]); w1.w = cvt_pk_bf16(v1[1][2], v1[1][3]);
                bf16_t* p = dst + (size_t)s * 64;
                *(u32x4*)p = w0; *(u32x4*)(p + 32) = w1;
            }
    }
};
struct EpiOutProj {
    static constexpr bool PERM16 = true; static constexpr bool PREDMA = false;
    const bf16_t* xn; const float* sig; bf16_t* x1b; unsigned char* x18;
    __device__ __forceinline__ void operator()(const f32x4 (&acc)[2][2][4][2], const Unit& u, int wr, int wc, int fr, int fq) const {
        const int row0 = u.pm * 256 + wr * 64 + fr, col0 = u.pn * 256 + wc * 64 + 16 * fq;
#pragma unroll
        for (int ai = 0; ai < 2; ++ai) {
            u32x4 xa[4][2]; float sg[4];
#pragma unroll
            for (int m = 0; m < 4; ++m) { const size_t off = (size_t)(row0 + ai * 128 + m * 16) * DMODEL + col0;
                xa[m][0] = __builtin_nontemporal_load((const u32x4*)(xn + off)); xa[m][1] = __builtin_nontemporal_load((const u32x4*)(xn + off + 8)); sg[m] = sig[row0 + ai * 128 + m * 16]; }
#pragma unroll
            for (int m = 0; m < 4; ++m) {
                const size_t off = (size_t)(row0 + ai * 128 + m * 16) * DMODEL + col0;
                f32x4 v[4];
#pragma unroll
                for (int bj = 0; bj < 2; ++bj)
#pragma unroll
                    for (int n = 0; n < 2; ++n) { const unsigned w0 = xa[m][bj][2 * n], w1 = xa[m][bj][2 * n + 1]; f32x4 xv; xv[0] = bf_lo(w0); xv[1] = bf_hi(w0); xv[2] = bf_lo(w1); xv[3] = bf_hi(w1);
                        v[2 * bj + n] = xv * sg[m] + acc[ai][bj][m][n] * (1.0f / 64.0f); }
                u32x4 wb0, wb1, w8;
                wb0.x = cvt_pk_bf16(v[0][0], v[0][1]); wb0.y = cvt_pk_bf16(v[0][2], v[0][3]); wb0.z = cvt_pk_bf16(v[1][0], v[1][1]); wb0.w = cvt_pk_bf16(v[1][2], v[1][3]);
                wb1.x = cvt_pk_bf16(v[2][0], v[2][1]); wb1.y = cvt_pk_bf16(v[2][2], v[2][3]); wb1.z = cvt_pk_bf16(v[3][0], v[3][1]); wb1.w = cvt_pk_bf16(v[3][2], v[3][3]);
                w8.x = pk4_fp8(v[0][0], v[0][1], v[0][2], v[0][3]); w8.y = pk4_fp8(v[1][0], v[1][1], v[1][2], v[1][3]); w8.z = pk4_fp8(v[2][0], v[2][1], v[2][2], v[2][3]); w8.w = pk4_fp8(v[3][0], v[3][1], v[3][2], v[3][3]);
                *(u32x4*)(x1b + off) = wb0; *(u32x4*)(x1b + off + 8) = wb1;
                *(u32x4*)(x18 + off) = w8;
            }
            asm volatile("" ::: "memory");
        }
    }
};
constexpr float SWC = 2.4554669595930156f;
struct EpiSwiglu {
    static constexpr bool PERM16 = false; static constexpr bool PREDMA = true;
    const LAS int* MS; const unsigned char* ws; const float *bg, *bu; unsigned char* mid;
    __device__ __forceinline__ void pre_dma(const Unit& u, int tid, int wid, LAS unsigned char* epm) const {
        const float* src;
        if (wid < 4) { const float* ent_rstd = (const float*)(ws + WS_ENT + (size_t)2 * NBIN * CAP * 4); const int rr = tid < u.nrows ? tid : u.nrows - 1; src = ent_rstd + moe_idx(MS, u.e, u.r0 + rr); }
        else { const int c = tid & 127; src = (wid < 6 ? bg : bu) + u.e * DEXP + u.pn * 128 + c; }
        __builtin_amdgcn_global_load_lds((const unsigned*)src, (LAS unsigned*)(epm + wid * 256), 4, 0, 0);
    }
    __device__ __forceinline__ void operator()(const f32x4 (&acc)[2][2][4][2], const Unit& u, int wr, int wc, int fr, int fq) const {
        const int col0 = u.pn * 128 + wc * 32 + 8 * fq;
        const LAS float* epm = (const LAS float*)((const LAS unsigned char*)MS + (EPM_OFF - MISC_OFF));
        float rs[8];
#pragma unroll
        for (int q = 0; q < 8; ++q) { const int r = (q >> 2) * 128 + wr * 64 + (q & 3) * 16 + fr; rs[q] = epm[r] * (1.0f / 64.0f); }
        f32x4 vbg[2], vbu[2];
#pragma unroll
        for (int n = 0; n < 2; ++n) { vbg[n] = *(const LAS f32x4*)(epm + 256 + wc * 32 + 8 * fq + 4 * n); vbu[n] = *(const LAS f32x4*)(epm + 384 + wc * 32 + 8 * fq + 4 * n); }
        const int mbase = MS[MS_BASE + u.e];
        auto row8 = [&](int ai, int m) -> u32x2 {
            const float rsq = rs[ai * 4 + m], rsqc = rsq * SWC, rsqi = rsq * (1.0f / SWC); unsigned wq[2];
#pragma unroll
            for (int n = 0; n < 2; ++n) {
                f32x2 o2[2];
#pragma unroll
                for (int h = 0; h < 2; ++h) {
                    const f32x2 ag = (f32x2){acc[ai][0][m][n][2 * h], acc[ai][0][m][n][2 * h + 1]}, au = (f32x2){acc[ai][1][m][n][2 * h], acc[ai][1][m][n][2 * h + 1]};
                    const f32x2 bgv = (f32x2){vbg[n][2 * h], vbg[n][2 * h + 1]}, buv = (f32x2){vbu[n][2 * h], vbu[n][2 * h + 1]};
                    f32x2 gc = ag * rsqc + bgv * SWC, uc = au * rsqi + (buv + 1.0f) * (1.0f / SWC);
                    gc.x = fminf(gc.x, 7.0f * SWC); gc.y = fminf(gc.y, 7.0f * SWC);
                    uc.x = __builtin_amdgcn_fmed3f(uc.x, -6.0f / SWC, 8.0f / SWC); uc.y = __builtin_amdgcn_fmed3f(uc.y, -6.0f / SWC, 8.0f / SWC);
                    f32x2 t; t.x = __builtin_amdgcn_exp2f(-gc.x); t.y = __builtin_amdgcn_exp2f(-gc.y);
                    t = t + 1.0f; f32x2 sg; sg.x = __builtin_amdgcn_rcpf(t.x); sg.y = __builtin_amdgcn_rcpf(t.y);
                    o2[h] = uc * (gc * sg);
                }
                int w_ = 0; w_ = __builtin_amdgcn_cvt_pk_fp8_f32(o2[0].x, o2[0].y, w_, false); w_ = __builtin_amdgcn_cvt_pk_fp8_f32(o2[1].x, o2[1].y, w_, true); wq[n] = (unsigned)w_;
            }
            u32x2 w; w.x = wq[0]; w.y = wq[1]; return w; };
        const int colw = u.pn * 128 + wc * 32 + 16 * (fq >> 1);
#pragma unroll
        for (int ai = 0; ai < 2; ++ai)
#pragma unroll
            for (int mp = 0; mp < 2; ++mp) {
                const u32x2 wa = row8(ai, 2 * mp), wb = row8(ai, 2 * mp + 1);
                const auto sx = __builtin_amdgcn_permlane16_swap(wa.x, wb.x, false, false), sy = __builtin_amdgcn_permlane16_swap(wa.y, wb.y, false, false);
                u32x4 w; w.x = sx[0]; w.y = sy[0]; w.z = sx[1]; w.w = sy[1];
                const int r = ai * 128 + wr * 64 + (2 * mp + (fq & 1)) * 16 + fr;
                if (r < u.nrows) *(u32x4*)(mid + (size_t)(mbase + u.r0 + r) * DEXP + colw) = w;
            }
    }
};
struct EpiDownY {
    static constexpr bool PERM16 = true; static constexpr bool PREDMA = true;
    const LAS int* MS; const unsigned char* ws; const float* bd; unsigned char* Y;
    __device__ __forceinline__ void pre_dma(const Unit& u, int tid, int wid, LAS unsigned char* epm) const {
        const float* src;
        if (wid < 4) { const float* ent_gate = (const float*)(ws + WS_ENT + (size_t)NBIN * CAP * 4); const int rr = tid < u.nrows ? tid : u.nrows - 1; src = ent_gate + moe_idx(MS, u.e, u.r0 + rr); }
        else { src = bd + u.e * DMODEL + u.pn * 256 + (tid & 255); }
        __builtin_amdgcn_global_load_lds((const unsigned*)src, (LAS unsigned*)(epm + wid * 256), 4, 0, 0);
    }
    __device__ __forceinline__ void operator()(const f32x4 (&acc)[2][2][4][2], const Unit& u, int wr, int wc, int fr, int fq) const {
        const int col0 = u.pn * 256 + wc * 64 + 16 * fq;
        const LAS float* epm = (const LAS float*)((const LAS unsigned char*)MS + (EPM_OFF - MISC_OFF));
        float gate[8];
#pragma unroll
        for (int q = 0; q < 8; ++q) { const int r = (q >> 2) * 128 + wr * 64 + (q & 3) * 16 + fr; gate[q] = epm[r] * (1.0f / 64.0f); }
        f32x4 vb[2][2];
#pragma unroll
        for (int bj = 0; bj < 2; ++bj)
#pragma unroll
            for (int n = 0; n < 2; ++n) vb[bj][n] = *(const LAS f32x4*)(epm + 256 + wc * 64 + 16 * fq + 8 * bj + 4 * n) * 64.0f;
        const int mbase = MS[MS_BASE + u.e] + u.r0;
#pragma unroll
        for (int ai = 0; ai < 2; ++ai)
#pragma unroll
            for (int m = 0; m < 4; ++m) {
                const int r = ai * 128 + wr * 64 + m * 16 + fr; const float gt = gate[ai * 4 + m];
                u32x4 w;
                unsigned wq[4];
#pragma unroll
                for (int bj = 0; bj < 2; ++bj)
#pragma unroll
                    for (int n = 0; n < 2; ++n) { const f32x4 a = (acc[ai][bj][m][n] + vb[bj][n]) * gt;
                        int w0 = 0; w0 = __builtin_amdgcn_cvt_pk_fp8_f32(a[0], a[1], w0, false); w0 = __builtin_amdgcn_cvt_pk_fp8_f32(a[2], a[3], w0, true); wq[2 * bj + n] = (unsigned)w0; }
                w.x = wq[0]; w.y = wq[1]; w.z = wq[2]; w.w = wq[3];
                if (r < u.nrows) *(u32x4*)(Y + (size_t)(mbase + r) * DMODEL + col0) = w;
            }
    }
};

struct EpiNull {
    static constexpr bool PERM16 = false; static constexpr bool PREDMA = false;
    __device__ __forceinline__ void operator()(const f32x4 (&acc)[2][2][4][2], const Unit& u, int wr, int wc, int fr, int fq) const {
#pragma unroll
        for (int ai = 0; ai < 2; ++ai)
#pragma unroll
            for (int bj = 0; bj < 2; ++bj)
#pragma unroll
                for (int m = 0; m < 4; ++m) asm volatile("" :: "v"(acc[ai][bj][m][0]), "v"(acc[ai][bj][m][1]));
    }
};
namespace attn_body {
using bf16 = __hip_bfloat16;
using s16x4 = __attribute__((ext_vector_type(4))) short;
using f32x16 = __attribute__((ext_vector_type(16))) float;
constexpr int D = 64, NW = 8, QBLK = 32, QB = QBLK * NW, KVBLK = 64, NT = SEQ / KVBLK;
__device__ __forceinline__ int crow(int r, int hi) { return (r & 3) + 8 * (r >> 2) + 4 * hi; }
#define SBAR() __builtin_amdgcn_sched_barrier(0)
constexpr int NSLOT = 3, SLOTB = 8192;
constexpr int LDS_K = 0, LDS_V = NSLOT * SLOTB, LDS_WS = 2 * NSLOT * SLOTB, LDS_OST = LDS_WS + NW * 64 * 4, ATTN_LDS_BYTES = LDS_OST + NW * 4096;
__device__ __forceinline__ void glds16(const void* gsrc, unsigned lds_dst) { unsigned keep;
  asm volatile("s_mov_b32 %0, m0\n\ts_mov_b32 m0, %2\n\ts_nop 0\n\tglobal_load_lds_dwordx4 %1, off\n\ts_mov_b32 m0, %0" : "=&s"(keep) : "v"(gsrc), "s"(lds_dst) : "memory"); }
typedef float f32x2_t __attribute__((ext_vector_type(2))); typedef __bf16 bf16x2_t __attribute__((ext_vector_type(2)));
__device__ __forceinline__ unsigned cvtpk_s(float lo, float hi) { f32x2_t v = {lo, hi}; bf16x2_t b = __builtin_convertvector(v, bf16x2_t); return __builtin_bit_cast(unsigned, b); }
#define WAIT_BAR(N) asm volatile("s_waitcnt vmcnt(" #N ") lgkmcnt(0)\n\ts_barrier" ::: "memory")

__device__ __forceinline__ void qkt(f32x16& p0, f32x16& p1, const char* Kslot, const bf16x8* qr, const f32x16& negm, int r32, int hi) {
  const char* kb = Kslot + hi * 1024 + r32 * 16;
  #pragma unroll
  for (int d0 = 0; d0 < 4; ++d0) {
    const bf16x8 b0 = *reinterpret_cast<const bf16x8*>(kb + d0 * 2048);
    const bf16x8 b1 = *reinterpret_cast<const bf16x8*>(kb + d0 * 2048 + 512);
    if (d0 == 0) { p0 = __builtin_amdgcn_mfma_f32_32x32x16_bf16(b0, qr[0], negm, 0, 0, 0); p1 = __builtin_amdgcn_mfma_f32_32x32x16_bf16(b1, qr[0], negm, 0, 0, 0); }
    else { p0 = __builtin_amdgcn_mfma_f32_32x32x16_bf16(b0, qr[d0], p0, 0, 0, 0); p1 = __builtin_amdgcn_mfma_f32_32x32x16_bf16(b1, qr[d0], p1, 0, 0, 0); } }
}
typedef __attribute__((address_space(3))) const char* lds_cptr;
typedef short v4i16_t __attribute__((ext_vector_type(4)));
__device__ __forceinline__ void kload8(bf16x8* kf, lds_cptr kp) {
  kf[0] = *(const LAS bf16x8*)(kp);        kf[1] = *(const LAS bf16x8*)(kp + 512);
  kf[2] = *(const LAS bf16x8*)(kp + 2048); kf[3] = *(const LAS bf16x8*)(kp + 2560);
  kf[4] = *(const LAS bf16x8*)(kp + 4096); kf[5] = *(const LAS bf16x8*)(kp + 4608);
  kf[6] = *(const LAS bf16x8*)(kp + 6144); kf[7] = *(const LAS bf16x8*)(kp + 6656);
}
__device__ __forceinline__ void kload2(bf16x8* kf, lds_cptr kp, int j) { kf[2 * j] = *(const LAS bf16x8*)(kp + j * 2048); kf[2 * j + 1] = *(const LAS bf16x8*)(kp + j * 2048 + 512); }
__device__ __forceinline__ s16x4 vtr(lds_cptr p) { return __builtin_bit_cast(s16x4, __builtin_amdgcn_ds_read_tr16_b64_v4i16((LAS v4i16_t*)p)); }
__device__ __forceinline__ void pv(f32x16* o, int vb, bf16x8 pa0, bf16x8 pa1, bf16x8 pa2, bf16x8 pa3) {
  #pragma unroll
  for (int d0 = 0; d0 < 2; ++d0) { s16x4 lo[4], hi[4];
    #pragma unroll
    for (int ks = 0; ks < 4; ++ks) {
      asm volatile("ds_read_b64_tr_b16 %0,%1 offset:%c2" : "=&v"(lo[ks]) : "v"(vb), "i"(d0 * 4096 + ks * 1024) : "memory");
      asm volatile("ds_read_b64_tr_b16 %0,%1 offset:%c2" : "=&v"(hi[ks]) : "v"(vb), "i"(d0 * 4096 + ks * 1024 + 512) : "memory"); }
    asm volatile("s_waitcnt lgkmcnt(0)" ::: "memory"); SBAR();
    #define PK(k) (bf16x8){lo[k][0], lo[k][1], lo[k][2], lo[k][3], hi[k][0], hi[k][1], hi[k][2], hi[k][3]}
    o[d0] = __builtin_amdgcn_mfma_f32_32x32x16_bf16(pa0, PK(0), o[d0], 0, 0, 0);
    o[d0] = __builtin_amdgcn_mfma_f32_32x32x16_bf16(pa1, PK(1), o[d0], 0, 0, 0);
    o[d0] = __builtin_amdgcn_mfma_f32_32x32x16_bf16(pa2, PK(2), o[d0], 0, 0, 0);
    o[d0] = __builtin_amdgcn_mfma_f32_32x32x16_bf16(pa3, PK(3), o[d0], 0, 0, 0);
    #undef PK
  }
}

template <int THRL> __device__ __forceinline__ void attn_unit(const bf16* Qrows, const bf16* __restrict__ Kh, const bf16* __restrict__ Vh, bf16* Orows, int opitch, char* shm,
                                                              const int primed, const bf16* Qnext, const bf16* Knext, bf16x8 (&qc)[4]) {
  int tid_ = threadIdx.x; asm volatile("" : "+v"(tid_));
  const int tid = tid_, lane = tid & 63, r32 = lane & 31, hi = lane >> 5; const int wid = __builtin_amdgcn_readfirstlane(tid >> 6);
  const bf16* Qw = Qrows + (long)(wid * QBLK) * D;
  const unsigned lds0 = (unsigned)(uintptr_t)shm;
  float* wsf = (float*)(shm + LDS_WS) + wid * 64;
  const bf16* ksrc = Kh + (long)lane * D + wid * 8;
  const bf16* vsrc = Vh + (long)(16 * (wid & 3) + (lane >> 2)) * D + (wid >> 2) * 32 + (lane & 3) * 8;
  const unsigned kdst = lds0 + LDS_K + wid * 1024, vdst = lds0 + LDS_V + wid * 1024;
  #define DMA_K(t, slot) glds16(ksrc + (long)(t) * KVBLK * D, (unsigned)__builtin_amdgcn_readfirstlane(kdst + (slot)))
  #define DMA_V(t, slot) glds16(vsrc + (long)(t) * KVBLK * D, (unsigned)__builtin_amdgcn_readfirstlane(vdst + (slot)))
  const int vb0 = (int)(lds0 + LDS_V) + ((lane >> 4) & 1) * 32 + (lane & 3) * 8 + (4 * hi + ((lane & 15) >> 2)) * 64;
  const char* Kbase = shm + LDS_K; bf16x8 kf[8];
  const lds_cptr shm3 = (lds_cptr)shm; const lds_cptr kp0 = shm3 + LDS_K + hi * 1024 + r32 * 16; const lds_cptr vp0 = shm3 + LDS_V + ((lane >> 4) & 1) * 32 + (lane & 3) * 8 + (4 * hi + ((lane & 15) >> 2)) * 64;
  bf16x8 qr[4];
  if (!primed) {
    DMA_K(0, 0); DMA_V(0, 0); DMA_K(1, SLOTB);
    #pragma unroll
    for (int d0 = 0; d0 < 4; ++d0) qr[d0] = *reinterpret_cast<const bf16x8*>(&Qw[(long)r32 * D + d0 * 16 + hi * 8]);
  } else {
    DMA_V(0, 0);
    #pragma unroll
    for (int d0 = 0; d0 < 4; ++d0) qr[d0] = qc[d0];
  }
  float l_reg = 0.f; f32x16 o[2]; o[0] = f32x16{}; o[1] = f32x16{}; const f32x16 negm = f32x16{};
  #define START(P0, P1) do { _Pragma("unroll") for (int r = 0; r < 16; ++r) P0[r] = __builtin_amdgcn_exp2f(P0[r]); } while (0)
  #define RESC() do { } while (0)
  f32x16 pA0, pA1, pB0, pB1;
  int sl_prev = 0, sl_cur = 0, sl_next = SLOTB;
  #define ROT() do { sl_prev = sl_cur; sl_cur = sl_next; sl_next = (sl_next == (NSLOT - 1) * SLOTB) ? 0 : sl_next + SLOTB; } while (0)
  if (!primed) DMA_K(2, 2 * SLOTB);
  WAIT_BAR(3);
  qkt(pA0, pA1, Kbase, qr, negm, r32, hi); asm volatile("s_nop 15\n\ts_nop 7" : "+v"(pA0), "+v"(pA1));
  START(pA0, pA1);
  _Pragma("unroll") for (int r = 0; r < 16; ++r) pA1[r] = __builtin_amdgcn_exp2f(pA1[r]);
  WAIT_BAR(0);
  DMA_K(3, 0); DMA_V(1, SLOTB);
  ROT();
  kload8(kf, kp0 + sl_cur);
  WAIT_BAR(2);
  s16x4 vlo[8], vhi[8]; u32x4 pw0, pw1, pw2, pw3;
  #define PKW(P, B) cvtpk_s(P[B], P[B + 1])
  #define PAF(k) __builtin_bit_cast(bf16x8, pw##k)
  #define VFR(i) (bf16x8){vlo[i][0], vlo[i][1], vlo[i][2], vlo[i][3], vhi[i][0], vhi[i][1], vhi[i][2], vhi[i][3]}
  #define PIN(x) asm volatile("" : "+v"(x))
  #define MX3(a, b, c) __builtin_fmaxf(__builtin_fmaxf((a), (b)), (c))
  #define GAPA(MF, A0, A1, A2, A3, W0, W1, PW) do { __builtin_amdgcn_s_setprio(1); MF; __builtin_amdgcn_s_setprio(0); sacc += A0; sacc += A1; sacc += A2; sacc += A3; PIN(sacc); W0; W1; PIN(PW); SBAR(); } while (0)
  #define EX(v) __builtin_amdgcn_exp2f(v)
  #define GAPB(MF, X, B) do { __builtin_amdgcn_s_setprio(1); MF; __builtin_amdgcn_s_setprio(0); X[B] = EX(X[B]); X[B + 1] = EX(X[B + 1]); X[B + 2] = EX(X[B + 2]); X[B + 3] = EX(X[B + 3]); PIN(X); SBAR(); } while (0)
  #define VRD(i) do { vlo[i] = vtr(vp_ + (((i) >> 2) * 4096 + ((i) & 3) * 1024)); vhi[i] = vtr(vp_ + (((i) >> 2) * 4096 + ((i) & 3) * 1024 + 512)); } while (0)
  #define KRD(G, j) do { if (G) { kload2(kf, kp0 + sl_next, j); SBAR(); } } while (0)
  #define STEP(C0, C1, P0, P1, t, GK, GV, GL) do { SBAR(); \
    const lds_cptr vp_ = vp0 + sl_prev; \
    VRD(0); SBAR(); float sacc = (P0[0] + P0[1]); \
    GAPA(C0 = __builtin_amdgcn_mfma_f32_32x32x16_bf16(kf[0], qr[0], negm, 0, 0, 0), P0[2], P0[3], P0[4], P0[5],     pw0[0] = PKW(P0, 0), pw0[1] = PKW(P0, 2), pw0); \
    VRD(4); SBAR(); GAPA(C1 = __builtin_amdgcn_mfma_f32_32x32x16_bf16(kf[1], qr[0], negm, 0, 0, 0), P0[6], P0[7], P0[8], P0[9],     pw0[2] = PKW(P0, 4), pw0[3] = PKW(P0, 6), pw0); \
    VRD(1); SBAR(); GAPA(C0 = __builtin_amdgcn_mfma_f32_32x32x16_bf16(kf[2], qr[1], C0, 0, 0, 0),   P0[10], P0[11], P0[12], P0[13], pw1[0] = PKW(P0, 8), pw1[1] = PKW(P0, 10), pw1); \
    VRD(5); SBAR(); GAPA(C1 = __builtin_amdgcn_mfma_f32_32x32x16_bf16(kf[3], qr[1], C1, 0, 0, 0),   P0[14], P0[15], P1[0], P1[1],   pw1[2] = PKW(P0, 12), pw1[3] = PKW(P0, 14), pw1); \
    VRD(2); SBAR(); GAPA(C0 = __builtin_amdgcn_mfma_f32_32x32x16_bf16(kf[4], qr[2], C0, 0, 0, 0),   P1[2], P1[3], P1[4], P1[5],     pw2[0] = PKW(P1, 0), pw2[1] = PKW(P1, 2), pw2); \
    VRD(6); SBAR(); GAPA(C1 = __builtin_amdgcn_mfma_f32_32x32x16_bf16(kf[5], qr[2], C1, 0, 0, 0),   P1[6], P1[7], P1[8], P1[9],     pw2[2] = PKW(P1, 4), pw2[3] = PKW(P1, 6), pw2); \
    VRD(3); SBAR(); GAPA(C0 = __builtin_amdgcn_mfma_f32_32x32x16_bf16(kf[6], qr[3], C0, 0, 0, 0),   P1[10], P1[11], P1[12], P1[13], pw3[0] = PKW(P1, 8), pw3[1] = PKW(P1, 10), pw3); \
    VRD(7); SBAR(); GAPA(C1 = __builtin_amdgcn_mfma_f32_32x32x16_bf16(kf[7], qr[3], C1, 0, 0, 0),   P1[14], P1[15], 0.f, 0.f,       pw3[2] = PKW(P1, 12), pw3[3] = PKW(P1, 14), pw3); \
    l_reg += sacc; \
    if (GK) { DMA_K((t) + 3, sl_cur); } if (GV) { DMA_V((t) + 1, sl_next); } \
    SBAR(); \
    GAPB(o[0] = __builtin_amdgcn_mfma_f32_32x32x16_bf16(PAF(0), VFR(0), o[0], 0, 0, 0), C0, 0); \
    GAPB(o[1] = __builtin_amdgcn_mfma_f32_32x32x16_bf16(PAF(0), VFR(4), o[1], 0, 0, 0), C0, 4); \
    KRD(GL, 0); GAPB(o[0] = __builtin_amdgcn_mfma_f32_32x32x16_bf16(PAF(1), VFR(1), o[0], 0, 0, 0), C0, 8); \
    KRD(GL, 1); GAPB(o[1] = __builtin_amdgcn_mfma_f32_32x32x16_bf16(PAF(1), VFR(5), o[1], 0, 0, 0), C0, 12); \
    KRD(GL, 2); GAPB(o[0] = __builtin_amdgcn_mfma_f32_32x32x16_bf16(PAF(2), VFR(2), o[0], 0, 0, 0), C1, 0); \
    KRD(GL, 3); GAPB(o[1] = __builtin_amdgcn_mfma_f32_32x32x16_bf16(PAF(2), VFR(6), o[1], 0, 0, 0), C1, 4); \
    GAPB(o[0] = __builtin_amdgcn_mfma_f32_32x32x16_bf16(PAF(3), VFR(3), o[0], 0, 0, 0), C1, 8); \
    GAPB(o[1] = __builtin_amdgcn_mfma_f32_32x32x16_bf16(PAF(3), VFR(7), o[1], 0, 0, 0), C1, 12); \
    } while (0)
  int t = 1;
  for (; t + 8 < NT; t += 6) {
    { const int sl_prev = 0, sl_cur = SLOTB, sl_next = 2 * SLOTB; STEP(pB0, pB1, pA0, pA1, t, true, true, true); WAIT_BAR(2); RESC(); }
    { const int sl_prev = SLOTB, sl_cur = 2 * SLOTB, sl_next = 0; STEP(pA0, pA1, pB0, pB1, t + 1, true, true, true); WAIT_BAR(2); RESC(); }
    { const int sl_prev = 2 * SLOTB, sl_cur = 0, sl_next = SLOTB; STEP(pB0, pB1, pA0, pA1, t + 2, true, true, true); WAIT_BAR(2); RESC(); }
    { const int sl_prev = 0, sl_cur = SLOTB, sl_next = 2 * SLOTB; STEP(pA0, pA1, pB0, pB1, t + 3, true, true, true); WAIT_BAR(2); RESC(); }
    { const int sl_prev = SLOTB, sl_cur = 2 * SLOTB, sl_next = 0; STEP(pB0, pB1, pA0, pA1, t + 4, true, true, true); WAIT_BAR(2); RESC(); }
    { const int sl_prev = 2 * SLOTB, sl_cur = 0, sl_next = SLOTB; STEP(pA0, pA1, pB0, pB1, t + 5, true, true, true); WAIT_BAR(2); RESC(); }
  }
  #define ENDW(tt) do { if ((tt) + 3 < NT) { WAIT_BAR(2); } else if ((tt) + 2 < NT) { WAIT_BAR(1); } else { WAIT_BAR(0); } } while (0)
  for (; t + 1 < NT; t += 2) {
    STEP(pB0, pB1, pA0, pA1, t, (t + 3 < NT), (t + 1 < NT), (t + 1 < NT));         ENDW(t);     RESC(); ROT();
    STEP(pA0, pA1, pB0, pB1, t + 1, (t + 4 < NT), (t + 2 < NT), (t + 2 < NT));     ENDW(t + 1); RESC(); ROT();
  }
  if (Knext) { const bf16* kn = Knext + (long)lane * D + wid * 8;
    glds16(kn, (unsigned)__builtin_amdgcn_readfirstlane(kdst)); glds16(kn + (long)KVBLK * D, (unsigned)__builtin_amdgcn_readfirstlane(kdst + SLOTB)); glds16(kn + (long)2 * KVBLK * D, (unsigned)__builtin_amdgcn_readfirstlane(kdst + 2 * SLOTB)); }
  STEP(pB0, pB1, pA0, pA1, NT - 1, false, false, false); RESC();
  { float sacc = pB0[0] + pB0[1]; _Pragma("unroll") for (int r = 2; r < 16; ++r) sacc += pB0[r]; _Pragma("unroll") for (int r = 0; r < 16; ++r) sacc += pB1[r]; l_reg += sacc;
    pw0 = (u32x4){PKW(pB0, 0), PKW(pB0, 2), PKW(pB0, 4), PKW(pB0, 6)}; pw1 = (u32x4){PKW(pB0, 8), PKW(pB0, 10), PKW(pB0, 12), PKW(pB0, 14)}; pw2 = (u32x4){PKW(pB1, 0), PKW(pB1, 2), PKW(pB1, 4), PKW(pB1, 6)}; pw3 = (u32x4){PKW(pB1, 8), PKW(pB1, 10), PKW(pB1, 12), PKW(pB1, 14)};
    SBAR(); pv(o, vb0 + sl_cur, PAF(0), PAF(1), PAF(2), PAF(3)); }
  if (Qnext) { const bf16* Qn = Qnext + (long)(wid * QBLK) * D;
    #pragma unroll
    for (int d0 = 0; d0 < 4; ++d0) qc[d0] = *reinterpret_cast<const bf16x8*>(&Qn[(long)r32 * D + d0 * 16 + hi * 8]); }
  else {
    #pragma unroll
    for (int d0 = 0; d0 < 4; ++d0) qc[d0] = bf16x8{}; }
  #undef PKW
  #undef PAF
  #undef VFR
  #undef PIN
  #undef MX3
  #undef GAPA
  #undef GAPB
  #undef EX
  #undef VRD
  #undef KRD
  #undef STEP
  #undef ENDW
  { auto rr = __builtin_amdgcn_permlane32_swap(__float_as_uint(l_reg), __float_as_uint(l_reg), false, false); l_reg = __uint_as_float(rr[0]) + __uint_as_float(rr[1]); }
  if (hi == 0) wsf[32 + r32] = l_reg; asm volatile("s_waitcnt lgkmcnt(0)" ::: "memory");
  float rli[16];
  #pragma unroll
  for (int r = 0; r < 16; ++r) rli[r] = __builtin_amdgcn_rcpf(wsf[32 + crow(r, hi)]);
  unsigned char* Ow = (unsigned char*)Orows + (long)(wid * QBLK) * opitch;
  { bf16* stg = (bf16*)(shm + LDS_OST) + wid * 2048;
    #pragma unroll
    for (int r = 0; r < 16; ++r) { const int orow = crow(r, hi); const float sc_ = rli[r] * CAT_SB;
      #pragma unroll
      for (int d0 = 0; d0 < 2; ++d0) stg[orow * 64 + d0 * 32 + r32] = __float2bfloat16(o[d0][r] * sc_); }
    asm volatile("s_waitcnt lgkmcnt(0)" ::: "memory");
    #pragma unroll
    for (int i = 0; i < 4; ++i) { const int row = i * 8 + (lane >> 3), ch = lane & 7; const u32x4 v = *(const u32x4*)(stg + row * 64 + ch * 8);
      u32x2 o8; o8.x = pk4_fp8(bf_lo(v.x), bf_hi(v.x), bf_lo(v.y), bf_hi(v.y)); o8.y = pk4_fp8(bf_lo(v.z), bf_hi(v.z), bf_lo(v.w), bf_hi(v.w));
      *(u32x2*)(Ow + (long)row * opitch + ch * 8) = o8; } }
  asm volatile("s_waitcnt lgkmcnt(0)\n\ts_barrier" ::: "memory");
  #undef DMA_K
  #undef DMA_V
  #undef START
  #undef RESC
  #undef ROT
}
template <int THRL> __device__ __forceinline__ void attn_unit_v128(const bf16* Qrows, const bf16* __restrict__ Kh, const bf16* __restrict__ Vh0, const bf16* __restrict__ Vh1, bf16* Orows, int opitch, char* shm,
                                                                   const int primed, const bf16* Qnext, const bf16* Knext, bf16x8 (&qc)[4]) {
  constexpr int L2_K = 0, L2_V = 3 * 8192, L2_WS = L2_V + 3 * 16384, L2_OST = L2_WS + NW * 64 * 4;
  const f32x16 zero16 = f32x16{};
  int tid_ = threadIdx.x; asm volatile("" : "+v"(tid_));
  const int tid = tid_, lane = tid & 63, r32 = lane & 31, hi = lane >> 5; const int wid = __builtin_amdgcn_readfirstlane(tid >> 6);
  const bf16* Qw = Qrows + (long)(wid * QBLK) * D;
  const unsigned lds0 = (unsigned)(uintptr_t)shm;
  float* wsf = (float*)(shm + L2_WS) + wid * 64;
  const bf16* ksrc = Kh + (long)lane * D + wid * 8;
  const long voff_ = (long)(16 * (wid & 3) + (lane >> 2)) * D + (wid >> 2) * 32 + (lane & 3) * 8;
  const bf16* vsrc = Vh0 + voff_; const bf16* vsrc1 = Vh1 + voff_;
  const unsigned kdst = lds0 + L2_K + wid * 1024, vdst = lds0 + L2_V + wid * 1024;
  #define DMA_K(t, slot) glds16(ksrc + (long)(t) * KVBLK * D, (unsigned)__builtin_amdgcn_readfirstlane(kdst + (slot)))
  #define DMA_V(t, slot) do { glds16(vsrc + (long)(t) * KVBLK * D, (unsigned)__builtin_amdgcn_readfirstlane(vdst + 2 * (slot))); \
                               glds16(vsrc1 + (long)(t) * KVBLK * D, (unsigned)__builtin_amdgcn_readfirstlane(vdst + 2 * (slot) + 8192)); } while (0)
  const char* Kbase = shm + L2_K; bf16x8 kf[8];
  const lds_cptr shm3 = (lds_cptr)shm; const lds_cptr kp0 = shm3 + L2_K + hi * 1024 + r32 * 16; const lds_cptr vp0 = shm3 + L2_V + ((lane >> 4) & 1) * 32 + (lane & 3) * 8 + (4 * hi + ((lane & 15) >> 2)) * 64;
  bf16x8 qr[4];
  if (!primed) {
    DMA_K(0, 0); DMA_V(0, 0); DMA_K(1, SLOTB);
    #pragma unroll
    for (int d0 = 0; d0 < 4; ++d0) qr[d0] = *reinterpret_cast<const bf16x8*>(&Qw[(long)r32 * D + d0 * 16 + hi * 8]);
  } else {
    DMA_V(0, 0);
    #pragma unroll
    for (int d0 = 0; d0 < 4; ++d0) qr[d0] = qc[d0];
  }
  float l_reg = 0.f; f32x16 o[4]; o[0] = f32x16{}; o[1] = f32x16{}; o[2] = f32x16{}; o[3] = f32x16{};
  #define START(P0, P1) do { _Pragma("unroll") for (int r = 0; r < 16; ++r) P0[r] = __builtin_amdgcn_exp2f(P0[r]); } while (0)
  #define RESC() do { } while (0)
  f32x16 pA0, pA1, pB0, pB1;
  int sl_prev = 0, sl_cur = 0, sl_next = SLOTB;
  #define ROT() do { sl_prev = sl_cur; sl_cur = sl_next; sl_next = (sl_next == (NSLOT - 1) * SLOTB) ? 0 : sl_next + SLOTB; } while (0)
  if (!primed) DMA_K(2, 2 * SLOTB);
  WAIT_BAR(4);
  { const f32x16 zero_ = f32x16{}; qkt(pA0, pA1, Kbase, qr, zero_, r32, hi); } asm volatile("s_nop 15\n\ts_nop 7" : "+v"(pA0), "+v"(pA1));
  START(pA0, pA1);
  _Pragma("unroll") for (int r = 0; r < 16; ++r) pA1[r] = __builtin_amdgcn_exp2f(pA1[r]);
  WAIT_BAR(0);
  DMA_K(3, 0); DMA_V(1, SLOTB);
  ROT();
  kload8(kf, kp0 + sl_cur);
  WAIT_BAR(3);
  s16x4 vlo[8], vhi[8]; u32x4 pw0, pw1, pw2, pw3;
  #define PKW(P, B) cvtpk_s(P[B], P[B + 1])
  #define PAF(k) __builtin_bit_cast(bf16x8, pw##k)
  #define VFR(i) (bf16x8){vlo[i][0], vlo[i][1], vlo[i][2], vlo[i][3], vhi[i][0], vhi[i][1], vhi[i][2], vhi[i][3]}
  #define PIN(x) asm volatile("" : "+v"(x))
  #define MX3(a, b, c) __builtin_fmaxf(__builtin_fmaxf((a), (b)), (c))
  #define GAPA(MF, A0, A1, A2, A3, W0, W1, PW) do { __builtin_amdgcn_s_setprio(1); MF; __builtin_amdgcn_s_setprio(0); sacc += A0; sacc += A1; sacc += A2; sacc += A3; PIN(sacc); W0; W1; PIN(PW); SBAR(); } while (0)
  #define EX(v) __builtin_amdgcn_exp2f(v)
  #define GAPB(MF, X, B) do { __builtin_amdgcn_s_setprio(1); MF; __builtin_amdgcn_s_setprio(0); X[B] = EX(X[B]); X[B + 1] = EX(X[B + 1]); PIN(X); SBAR(); } while (0)
  #define VRD(c) do { vlo[(c) & 7] = vtr(vp_ + (((c) & 3) * 4096 + ((c) >> 2) * 1024)); vhi[(c) & 7] = vtr(vp_ + (((c) & 3) * 4096 + ((c) >> 2) * 1024 + 512)); } while (0)
  #define KRD(G, j) do { if (G) { kload2(kf, kp0 + sl_next, j); SBAR(); } } while (0)
  #define PVM(c, X, B) GAPB(o[(c) & 3] = __builtin_amdgcn_mfma_f32_32x32x16_bf16(PAFI((c) >> 2), VFR((c) & 7), o[(c) & 3], 0, 0, 0), X, B)
  #define PAFI(k) ((k) == 0 ? PAF(0) : (k) == 1 ? PAF(1) : (k) == 2 ? PAF(2) : PAF(3))
  #define STEP(C0, C1, P0, P1, t, GK, GV, GL) do { SBAR(); \
    const lds_cptr vp_ = vp0 + 2 * sl_prev; \
    VRD(0); SBAR(); float sacc = (P0[0] + P0[1]); \
    GAPA(C0 = __builtin_amdgcn_mfma_f32_32x32x16_bf16(kf[0], qr[0], zero16, 0, 0, 0), P0[2], P0[3], P0[4], P0[5],     pw0[0] = PKW(P0, 0), pw0[1] = PKW(P0, 2), pw0); \
    VRD(1); SBAR(); GAPA(C1 = __builtin_amdgcn_mfma_f32_32x32x16_bf16(kf[1], qr[0], zero16, 0, 0, 0), P0[6], P0[7], P0[8], P0[9],     pw0[2] = PKW(P0, 4), pw0[3] = PKW(P0, 6), pw0); \
    VRD(2); SBAR(); GAPA(C0 = __builtin_amdgcn_mfma_f32_32x32x16_bf16(kf[2], qr[1], C0, 0, 0, 0),   P0[10], P0[11], P0[12], P0[13], pw1[0] = PKW(P0, 8), pw1[1] = PKW(P0, 10), pw1); \
    VRD(3); SBAR(); GAPA(C1 = __builtin_amdgcn_mfma_f32_32x32x16_bf16(kf[3], qr[1], C1, 0, 0, 0),   P0[14], P0[15], P1[0], P1[1],   pw1[2] = PKW(P0, 12), pw1[3] = PKW(P0, 14), pw1); \
    VRD(4); SBAR(); GAPA(C0 = __builtin_amdgcn_mfma_f32_32x32x16_bf16(kf[4], qr[2], C0, 0, 0, 0),   P1[2], P1[3], P1[4], P1[5],     pw2[0] = PKW(P1, 0), pw2[1] = PKW(P1, 2), pw2); \
    VRD(5); SBAR(); GAPA(C1 = __builtin_amdgcn_mfma_f32_32x32x16_bf16(kf[5], qr[2], C1, 0, 0, 0),   P1[6], P1[7], P1[8], P1[9],     pw2[2] = PKW(P1, 4), pw2[3] = PKW(P1, 6), pw2); \
    VRD(6); SBAR(); GAPA(C0 = __builtin_amdgcn_mfma_f32_32x32x16_bf16(kf[6], qr[3], C0, 0, 0, 0),   P1[10], P1[11], P1[12], P1[13], pw3[0] = PKW(P1, 8), pw3[1] = PKW(P1, 10), pw3); \
    VRD(7); SBAR(); GAPA(C1 = __builtin_amdgcn_mfma_f32_32x32x16_bf16(kf[7], qr[3], C1, 0, 0, 0),   P1[14], P1[15], 0.f, 0.f,       pw3[2] = PKW(P1, 12), pw3[3] = PKW(P1, 14), pw3); \
    l_reg += sacc; \
    if (GK) { DMA_K((t) + 3, sl_cur); } if (GV) { DMA_V((t) + 1, sl_next); } \
    SBAR(); \
    PVM(0, C0, 0);  VRD(8);  SBAR(); \
    PVM(1, C0, 2);  VRD(9);  SBAR(); \
    PVM(2, C0, 4);  VRD(10); SBAR(); \
    PVM(3, C0, 6);  VRD(11); SBAR(); \
    KRD(GL, 0); PVM(4, C0, 8);  VRD(12); SBAR(); \
    PVM(5, C0, 10); VRD(13); SBAR(); \
    KRD(GL, 1); PVM(6, C0, 12); VRD(14); SBAR(); \
    PVM(7, C0, 14); VRD(15); SBAR(); \
    KRD(GL, 2); PVM(8, C1, 0); \
    PVM(9, C1, 2); \
    KRD(GL, 3); PVM(10, C1, 4); \
    PVM(11, C1, 6); \
    PVM(12, C1, 8); \
    PVM(13, C1, 10); \
    PVM(14, C1, 12); \
    PVM(15, C1, 14); \
    } while (0)
  int t = 1;
  for (; t + 8 < NT; t += 6) {
    { const int sl_prev = 0, sl_cur = SLOTB, sl_next = 2 * SLOTB; STEP(pB0, pB1, pA0, pA1, t, true, true, true); WAIT_BAR(3); RESC(); }
    { const int sl_prev = SLOTB, sl_cur = 2 * SLOTB, sl_next = 0; STEP(pA0, pA1, pB0, pB1, t + 1, true, true, true); WAIT_BAR(3); RESC(); }
    { const int sl_prev = 2 * SLOTB, sl_cur = 0, sl_next = SLOTB; STEP(pB0, pB1, pA0, pA1, t + 2, true, true, true); WAIT_BAR(3); RESC(); }
    { const int sl_prev = 0, sl_cur = SLOTB, sl_next = 2 * SLOTB; STEP(pA0, pA1, pB0, pB1, t + 3, true, true, true); WAIT_BAR(3); RESC(); }
    { const int sl_prev = SLOTB, sl_cur = 2 * SLOTB, sl_next = 0; STEP(pB0, pB1, pA0, pA1, t + 4, true, true, true); WAIT_BAR(3); RESC(); }
    { const int sl_prev = 2 * SLOTB, sl_cur = 0, sl_next = SLOTB; STEP(pA0, pA1, pB0, pB1, t + 5, true, true, true); WAIT_BAR(3); RESC(); }
  }
  #define ENDW(tt) do { if ((tt) + 3 < NT) { WAIT_BAR(3); } else if ((tt) + 2 < NT) { WAIT_BAR(2); } else { WAIT_BAR(0); } } while (0)
  for (; t + 1 < NT; t += 2) {
    STEP(pB0, pB1, pA0, pA1, t, (t + 3 < NT), (t + 1 < NT), (t + 1 < NT));         ENDW(t);     RESC(); ROT();
    STEP(pA0, pA1, pB0, pB1, t + 1, (t + 4 < NT), (t + 2 < NT), (t + 2 < NT));     ENDW(t + 1); RESC(); ROT();
  }
  if (Knext) { const bf16* kn = Knext + (long)lane * D + wid * 8;
    glds16(kn, (unsigned)__builtin_amdgcn_readfirstlane(kdst)); glds16(kn + (long)KVBLK * D, (unsigned)__builtin_amdgcn_readfirstlane(kdst + SLOTB)); glds16(kn + (long)2 * KVBLK * D, (unsigned)__builtin_amdgcn_readfirstlane(kdst + 2 * SLOTB)); }
  STEP(pB0, pB1, pA0, pA1, NT - 1, false, false, false); RESC();
  { float sacc = pB0[0] + pB0[1]; _Pragma("unroll") for (int r = 2; r < 16; ++r) sacc += pB0[r]; _Pragma("unroll") for (int r = 0; r < 16; ++r) sacc += pB1[r]; l_reg += sacc;
    pw0 = (u32x4){PKW(pB0, 0), PKW(pB0, 2), PKW(pB0, 4), PKW(pB0, 6)}; pw1 = (u32x4){PKW(pB0, 8), PKW(pB0, 10), PKW(pB0, 12), PKW(pB0, 14)}; pw2 = (u32x4){PKW(pB1, 0), PKW(pB1, 2), PKW(pB1, 4), PKW(pB1, 6)}; pw3 = (u32x4){PKW(pB1, 8), PKW(pB1, 10), PKW(pB1, 12), PKW(pB1, 14)};
    SBAR(); const lds_cptr vp_ = vp0 + 2 * sl_cur;
    _Pragma("unroll") for (int c = 0; c < 16; ++c) { const s16x4 lo_ = vtr(vp_ + ((c & 3) * 4096 + (c >> 2) * 1024)), hi_ = vtr(vp_ + ((c & 3) * 4096 + (c >> 2) * 1024 + 512));
      const bf16x8 vf_ = (bf16x8){lo_[0], lo_[1], lo_[2], lo_[3], hi_[0], hi_[1], hi_[2], hi_[3]};
      o[c & 3] = __builtin_amdgcn_mfma_f32_32x32x16_bf16(PAFI(c >> 2), vf_, o[c & 3], 0, 0, 0); } }
  if (Qnext) { const bf16* Qn = Qnext + (long)(wid * QBLK) * D;
    #pragma unroll
    for (int d0 = 0; d0 < 4; ++d0) qc[d0] = *reinterpret_cast<const bf16x8*>(&Qn[(long)r32 * D + d0 * 16 + hi * 8]); }
  else {
    #pragma unroll
    for (int d0 = 0; d0 < 4; ++d0) qc[d0] = bf16x8{}; }
  #undef PKW
  #undef PAF
  #undef VFR
  #undef PIN
  #undef MX3
  #undef GAPA
  #undef GAPB
  #undef EX
  #undef VRD
  #undef KRD
  #undef STEP
  #undef ENDW
  #undef PVM
  #undef PAFI
  { auto rr = __builtin_amdgcn_permlane32_swap(__float_as_uint(l_reg), __float_as_uint(l_reg), false, false); l_reg = __uint_as_float(rr[0]) + __uint_as_float(rr[1]); }
  if (hi == 0) wsf[32 + r32] = l_reg; asm volatile("s_waitcnt lgkmcnt(0)" ::: "memory");
  float rli[16];
  #pragma unroll
  for (int r = 0; r < 16; ++r) rli[r] = __builtin_amdgcn_rcpf(wsf[32 + crow(r, hi)]);
  bf16* Ow = Orows + (long)(wid * QBLK) * opitch;
  { bf16* stg = (bf16*)(shm + L2_OST) + wid * 2048;
    #pragma unroll
    for (int hf = 0; hf < 2; ++hf) {
      #pragma unroll
      for (int r = 0; r < 16; ++r) { const int orow = crow(r, hi);
        #pragma unroll
        for (int d0 = 0; d0 < 2; ++d0) stg[orow * 64 + d0 * 32 + r32] = __float2bfloat16(o[hf * 2 + d0][r] * rli[r]); }
      asm volatile("s_waitcnt lgkmcnt(0)" ::: "memory");
      #pragma unroll
      for (int i = 0; i < 4; ++i) { const int row = i * 8 + (lane >> 3), ch = lane & 7; const u32x4 v = *(const u32x4*)(stg + row * 64 + ch * 8); *(u32x4*)(Ow + (long)row * opitch + hf * 64 + ch * 8) = v; }
      asm volatile("s_waitcnt lgkmcnt(0)" ::: "memory");
    } }
  asm volatile("s_waitcnt lgkmcnt(0)\n\ts_barrier" ::: "memory");
  #undef DMA_K
  #undef DMA_V
  #undef START
  #undef RESC
  #undef ROT
}
#undef SBAR
#undef WAIT_BAR
}

struct P0Item { const float* src; const float* ks; unsigned char* dst; int ldw; int fp8; float kmul; };
__device__ __forceinline__ void p0_load(const P0Item& I, f32x4 (&v)[8], float (&sc)[8], int lane) {
#pragma unroll
    for (int i = 0; i < 8; ++i) { const int kk = (lane >> 3) + 8 * i; v[i] = __builtin_nontemporal_load((const f32x4*)(I.src + (size_t)kk * I.ldw + 4 * (lane & 7))); sc[i] = I.ks ? I.ks[kk] : 1.0f; }
}
__device__ __forceinline__ void p0_process(const P0Item& I, const f32x4 (&v)[8], const float (&sc)[8], LAS float* scr, int lane) {
    const float mul = (I.fp8 ? 64.0f : 1.0f) * I.kmul;
#pragma unroll
    for (int i = 0; i < 8; ++i) { const int kk = (lane >> 3) + 8 * i; const f32x4 w = v[i] * (sc[i] * mul);
        LAS float* s = scr + kk * 33 + 4 * (lane & 7); s[0] = w[0]; s[1] = w[1]; s[2] = w[2]; s[3] = w[3]; }
    asm volatile("s_waitcnt lgkmcnt(0)" ::: "memory");
    const int c = lane & 7;
    if (I.fp8) {
#pragma unroll
        for (int j = 0; j < 4; ++j) { const int n = (lane >> 3) + 8 * j; const LAS float* s = scr + (8 * c) * 33 + n;
            u32x2 o; o.x = pk4_fp8(s[0 * 33], s[1 * 33], s[2 * 33], s[3 * 33]); o.y = pk4_fp8(s[4 * 33], s[5 * 33], s[6 * 33], s[7 * 33]);
            *(u32x2*)(I.dst + (size_t)n * KDIM + 8 * c) = o; }
    } else {
#pragma unroll
        for (int j = 0; j < 4; ++j) { const int n = (lane >> 3) + 8 * j; const LAS float* s = scr + (8 * c) * 33 + n;
            u32x4 o; o.x = cvt_pk_bf16(s[0 * 33], s[1 * 33]); o.y = cvt_pk_bf16(s[2 * 33], s[3 * 33]); o.z = cvt_pk_bf16(s[4 * 33], s[5 * 33]); o.w = cvt_pk_bf16(s[6 * 33], s[7 * 33]);
            *(u32x4*)(I.dst + (size_t)n * KDIM * 2 + 16 * c) = o; }
    }
    asm volatile("s_waitcnt lgkmcnt(0)" ::: "memory");
}
constexpr int P0_IN = 16 * 72, P0_OUT = 16 * 32, P0_GU = NEXP * 16 * 64, P0_DN = NEXP * 16 * 32, P0_NITEMS = P0_IN + P0_OUT + P0_GU + P0_DN;
__device__ __forceinline__ P0Item p0_decode(const Frame& F, int it) {
    P0Item I; I.kmul = 1.0f; int r = it;
    if (r < P0_IN) { const int kb = r / 72, nb = r % 72, pn = nb >> 3, bj = (nb >> 2) & 1, wc = nb & 3;
        I.src = F.in[I_WIN] + (size_t)(64 * kb) * NPROJ + 256 * pn + 64 * wc + 32 * bj; I.ldw = NPROJ; I.ks = F.in[I_N1G] + 64 * kb; I.fp8 = 0;
        I.dst = F.ws + WS_WIN + ((size_t)(32 * nb) * KDIM + 64 * kb) * 2; return I; }
    r -= P0_IN;
    if (r < P0_OUT) { const int kb = r / 32, nb = r % 32;
        I.src = F.in[I_WOUT] + (size_t)(64 * kb) * DMODEL + 32 * nb; I.ldw = DMODEL; I.ks = nullptr; I.fp8 = 1; I.kmul = (64 * kb < 512) ? (1.0f / CAT_SA) : (1.0f / CAT_SB);
        I.dst = F.ws + WS_WOUT + ((size_t)(32 * nb) * KDIM + 64 * kb); return I; }
    r -= P0_OUT;
    if (r < P0_GU) { const int e = r >> 10, q = r & 1023, kb = q >> 6, nb = q & 63, pn = nb >> 3, bj = (nb >> 2) & 1, jb = nb & 3;
        I.src = (bj ? F.in[I_WU] : F.in[I_WG]) + (size_t)e * DMODEL * DEXP + (size_t)(64 * kb) * DEXP + 128 * pn + 32 * jb; I.ldw = DEXP; I.ks = F.in[I_N2G] + 64 * kb; I.fp8 = 1;
        I.dst = F.ws + WS_WGU + ((size_t)e * 2048 + 32 * nb) * KDIM + 64 * kb; return I; }
    r -= P0_GU;
    { const int e = r >> 9, q = r & 511, kb = q >> 5, nb = q & 31;
        I.src = F.in[I_WDN] + (size_t)e * DEXP * DMODEL + (size_t)(64 * kb) * DMODEL + 32 * nb; I.ldw = DMODEL; I.ks = nullptr; I.fp8 = 1;
        I.dst = F.ws + WS_WD + ((size_t)e * 1024 + 32 * nb) * KDIM + 64 * kb; return I; }
}
__device__ __forceinline__ void p0_convert_range(const Frame& F, int it0, int it1, int w, int nw, LAS float* scr, int lane) {
    int it = it0 + w;
    if (it < it1) {
        P0Item A = p0_decode(F, it), B = A; f32x4 va[8], vb[8]; float sa[8], sb[8];
        p0_load(A, va, sa, lane);
        for (;;) {
            const bool hb = it + nw < it1; if (hb) { B = p0_decode(F, it + nw); p0_load(B, vb, sb, lane); }
            p0_process(A, va, sa, scr, lane);
            if (!hb) break; it += nw;
            const bool ha = it + nw < it1; if (ha) { A = p0_decode(F, it + nw); p0_load(A, va, sa, lane); }
            p0_process(B, vb, sb, scr, lane);
            if (!ha) break; it += nw;
        }
    }
}
__device__ __forceinline__ void p0_prologue(Frame& F) {
    LAS float* scr = (LAS float*)(F.lds + F.wave * 16384);
    const int gw = F.vcu * NWAVES + F.wave, NGW = F.G * NWAVES, lane = F.lane;
    p0_convert_range(F, 0, P0_IN + P0_OUT, gw, NGW, scr, lane);
    { bf16_t* XN = (bf16_t*)(F.ws + WS_XN); float* sig = (float*)(F.ws + WS_SIG);
      for (int m = gw; m < MTOK; m += 2 * NGW) {
          const int m2 = m + NGW; const bool h2 = m2 < MTOK;
          const float* xr = F.in[I_X] + (size_t)m * DMODEL + 8 * lane; const float* xr2 = F.in[I_X] + (size_t)(h2 ? m2 : m) * DMODEL + 8 * lane;
          f32x4 v[4], w[4]; float s = 0.f, s2 = 0.f;
#pragma unroll
          for (int j = 0; j < 2; ++j) { v[2 * j] = __builtin_nontemporal_load((const f32x4*)(xr + 512 * j)); v[2 * j + 1] = __builtin_nontemporal_load((const f32x4*)(xr + 512 * j + 4));
                                        w[2 * j] = __builtin_nontemporal_load((const f32x4*)(xr2 + 512 * j)); w[2 * j + 1] = __builtin_nontemporal_load((const f32x4*)(xr2 + 512 * j + 4)); }
#pragma unroll
          for (int j = 0; j < 4; ++j) { s += (v[j].x * v[j].x + v[j].y * v[j].y) + (v[j].z * v[j].z + v[j].w * v[j].w); s2 += (w[j].x * w[j].x + w[j].y * w[j].y) + (w[j].z * w[j].z + w[j].w * w[j].w); }
          const float sg = sqrtf(wave_sum(s) * (1.0f / DMODEL) + EPS), sg2 = sqrtf(wave_sum(s2) * (1.0f / DMODEL) + EPS);
          const float rstd = 1.0f / sg, rstd2 = 1.0f / sg2;
          bf16_t* o8 = XN + (size_t)m * DMODEL + 8 * lane; bf16_t* o82 = XN + (size_t)m2 * DMODEL + 8 * lane;
#pragma unroll
          for (int j = 0; j < 2; ++j) { const f32x4 y0 = v[2 * j] * rstd, y1 = v[2 * j + 1] * rstd; u32x4 t; t.x = cvt_pk_bf16(y0.x, y0.y); t.y = cvt_pk_bf16(y0.z, y0.w); t.z = cvt_pk_bf16(y1.x, y1.y); t.w = cvt_pk_bf16(y1.z, y1.w); *(u32x4*)(o8 + 512 * j) = t; }
          if (lane == 0) sig[m] = sg;
          if (h2) {
#pragma unroll
              for (int j = 0; j < 2; ++j) { const f32x4 y0 = w[2 * j] * rstd2, y1 = w[2 * j + 1] * rstd2; u32x4 t; t.x = cvt_pk_bf16(y0.x, y0.y); t.y = cvt_pk_bf16(y0.z, y0.w); t.z = cvt_pk_bf16(y1.x, y1.y); t.w = cvt_pk_bf16(y1.z, y1.w); *(u32x4*)(o82 + 512 * j) = t; }
              if (lane == 0) sig[m2] = sg2; }
      } }
    if (blockIdx.x == 0 && F.tid < 64) { float* tab = (float*)(F.ws + WS_TAB); const int i = F.tid & 31;
        const float f = (F.tid < 32) ? powf(10000.0f, -(float)(2 * i) / 64.0f) : powf(10000.0f, -(float)(2 * (i & 15)) / 32.0f);
        tab[F.tid] = (float)((double)f * 0.15915494309189535); }
    { unsigned char* wr = F.ws + WS_WR; const float* rw = F.in[I_RW]; const float* g2 = F.in[I_N2G];
      for (int idx = gw * 64 + lane; idx < DMODEL * NEXP; idx += NGW * 64) { const int k = idx >> 5, e = idx & 31; const float w = rw[idx] * g2[k];
          const unsigned hi = cvt_pk_bf16(w, 0.f) & 0xffffu; const float rem = w - __uint_as_float(hi << 16); const unsigned lo = cvt_pk_bf16(rem, 0.f) & 0xffffu;
          const int off = e * 2048 + (((k >> 3) ^ (e & 15)) << 4) + (k & 7) * 2;
          *(bf16_t*)(wr + off) = (bf16_t)hi; *(bf16_t*)(wr + 65536 + off) = (bf16_t)lo; } }
    if (blockIdx.x == 0) {
        unsigned* ctl = (unsigned*)(F.ws + WS_CTL);
        { float* gnt = (float*)(F.ws + WS_GN);
          if (F.tid < 64) gnt[F.tid] = F.in[I_AQG][F.tid]; else if (F.tid < 128) gnt[F.tid] = F.in[I_AKG][F.tid - 64];
          else if (F.tid < 192) gnt[F.tid] = F.in[I_BQG][F.tid - 128]; else if (F.tid < 256) gnt[F.tid] = F.in[I_BKG][F.tid - 192]; }
        if (F.tid < NBIN) ctl[F.tid] = 0u;
        if (F.tid >= 448) {
            const int i = F.tid - 448;
            const float d1 = wave_sum(F.in[I_LQ1][i] * F.in[I_LK1][i]), d2 = wave_sum(F.in[I_LQ2][i] * F.in[I_LK2][i]);
            if (i == 0) ((float*)ctl)[256] = expf(d1) - expf(d2) + LAM_INIT;
        }
    }
}

__device__ __forceinline__ void p2_attention(Frame& F, char* shm) {
    using abf = attn_body::bf16;
    const abf* QA = (const abf*)(F.ws + WS_QA); const abf* KA = (const abf*)(F.ws + WS_KA); const abf* VA = (const abf*)(F.ws + WS_VA);
    const abf* QB = (const abf*)(F.ws + WS_QB); const abf* KB = (const abf*)(F.ws + WS_KB); const abf* VB = (const abf*)(F.ws + WS_VB);
    abf* CAT = (abf*)(F.ws + WS_CAT); abf* OAPW = (abf*)(F.ws + WS_OAP) + (size_t)blockIdx.x * 131072;
    const size_t HS = (size_t)SEQ * 64;
    auto combine = [&](const abf* OAP, int b, int h, int qb) {
        const float lam = ((const float*)(F.ws + WS_CTL))[256];
        int ctid = threadIdx.x; asm volatile("" : "+v"(ctid));
        const int chunk = ctid & 15, rlo = ctid >> 4;
        const u32x4* p1 = (const u32x4*)((const bf16_t*)OAP + rlo * 128 + chunk * 8); const u32x4* p2 = (const u32x4*)((const bf16_t*)OAP + 32768 + rlo * 128 + chunk * 8);
        const float* sg = F.in[I_SUBG] + chunk * 8;
        const f32x4 g0 = *(const f32x4*)sg, g1 = *(const f32x4*)(sg + 4);
        u32x4 av[8], dv[8];
#pragma unroll
        for (int ps = 0; ps < 8; ++ps) { av[ps] = p1[ps * 512]; dv[ps] = p2[ps * 512]; }
        unsigned char* dst = (unsigned char*)CAT + ((size_t)b * SEQ + qb * 256 + rlo) * DMODEL + h * 128 + chunk * 8;
#pragma unroll
        for (int ps = 0; ps < 8; ++ps) {
            const unsigned aw[4] = {av[ps].x, av[ps].y, av[ps].z, av[ps].w}, dw[4] = {dv[ps].x, dv[ps].y, dv[ps].z, dv[ps].w};
            float ov[8]; float ss = 0.f;
#pragma unroll
            for (int q = 0; q < 4; ++q) { const float lo = bf_lo(aw[q]) - lam * bf_lo(dw[q]), hi2 = bf_hi(aw[q]) - lam * bf_hi(dw[q]); ov[q * 2] = lo; ov[q * 2 + 1] = hi2; ss += lo * lo + hi2 * hi2; }
            ss += xor1f(ss); ss += xor2f(ss); ss += xor4f(ss); ss += xor8f(ss);
            const float rs = __builtin_amdgcn_rsqf(ss * (1.0f / 128.0f) + EPS) * ((1.0f - LAM_INIT) * CAT_SA);
            u32x2 w;
            w.x = pk4_fp8(ov[0] * rs * g0[0], ov[1] * rs * g0[1], ov[2] * rs * g0[2], ov[3] * rs * g0[3]);
            w.y = pk4_fp8(ov[4] * rs * g1[0], ov[5] * rs * g1[1], ov[6] * rs * g1[2], ov[7] * rs * g1[3]);
            *(u32x2*)(dst + (size_t)ps * 32 * DMODEL) = w;
        }
    };
    const int conv_slot = F.vcu % 6; int jn = 0; bool conv_done = false;
    int pend = 0, pb = 0, ph = 0, pqb = 0, pbuf = 0;
    bf16x8 qc[4]; int primed = 0;
#pragma unroll
    for (int d0 = 0; d0 < 4; ++d0) qc[d0] = bf16x8{};
    for (int J = F.vcu; J < 1536; J += F.G, ++jn) {
        if (jn == conv_slot) { conv_done = true; __syncthreads();
            { int t_ = threadIdx.x; asm volatile("" : "+v"(t_)); F.tid = t_; F.lane = t_ & 63; }
            p0_convert_range(F, P0_IN + P0_OUT, P0_NITEMS, F.vcu * NWAVES + F.wave, F.G * NWAVES, (LAS float*)(F.lds + F.wave * 16384), F.lane); __syncthreads(); }
        const bool isA = J < 512;
        int b, h = 0, qb, kvh = 0, g = 0;
        if (isA) { const int c = J >> 8, v = J & 255; b = v >> 5; const int w = (c << 5) | (v & 31); h = w >> 4; qb = w & 15; }
        else { const int ui = J - 512, i = ui >> 8, v = ui & 255; b = v >> 5; const int w = i * 32 + (v & 31); kvh = w >> 6; g = (w >> 4) & 3; qb = w & 15; }
        const abf* Qn1 = nullptr; const abf* Kn1 = nullptr;
        { const int Jn = J + F.G;
          if (Jn < 1536 && jn + 1 != conv_slot) {
              if (Jn < 512) { const int c = Jn >> 8, v = Jn & 255, bn = v >> 5, w = (c << 5) | (v & 31), hn = w >> 4, qbn = w & 15;
                  Qn1 = QA + (size_t)(bn * 8 + hn * 2) * HS + (size_t)qbn * 256 * 64; Kn1 = KA + (size_t)(bn * 8 + hn * 2) * HS; }
              else { const int ui = Jn - 512, i = ui >> 8, v = ui & 255, bn = v >> 5, w = i * 32 + (v & 31), kvhn = w >> 6, gn = (w >> 4) & 3, qbn = w & 15;
                  Qn1 = QB + (size_t)(bn * 8 + kvhn * 4 + gn) * HS + (size_t)qbn * 256 * 64; Kn1 = KB + (size_t)(bn * 2 + kvhn) * HS; } } }
        if (isA) {
            abf* OAP = OAPW + (size_t)(jn & 1) * 65536;
            if (pend && pbuf == (jn & 1)) { asm volatile("s_waitcnt vmcnt(0)" ::: "memory"); __syncthreads(); combine(OAPW + (size_t)pbuf * 65536, pb, ph, pqb); pend = 0; asm volatile("s_waitcnt vmcnt(0)" ::: "memory"); __syncthreads(); }
#pragma unroll 1
            for (int br = 0; br < 2; ++br) {
                const abf* Qn = br == 0 ? QA + (size_t)(b * 8 + h * 2 + 1) * HS + (size_t)qb * 256 * 64 : Qn1;
                const abf* Kn = br == 0 ? KA + (size_t)(b * 8 + h * 2 + 1) * HS : Kn1;
                attn_body::attn_unit_v128<8>(QA + (size_t)(b * 8 + h * 2 + br) * HS + (size_t)qb * 256 * 64, KA + (size_t)(b * 8 + h * 2 + br) * HS,
                                             VA + (size_t)(b * 8 + h * 2) * HS, VA + (size_t)(b * 8 + h * 2 + 1) * HS, OAP + br * 32768, 128, shm, primed, Qn, Kn, qc);
                primed = (Kn != nullptr);
                if (br == 0 && pend) { combine(OAPW + (size_t)pbuf * 65536, pb, ph, pqb); pend = 0; }
            }
            pend = 1; pb = b; ph = h; pqb = qb; pbuf = jn & 1;
        } else { const int qh = kvh * 4 + g;
            attn_body::attn_unit<8>(QB + (size_t)(b * 8 + qh) * HS + (size_t)qb * 256 * 64, KB + (size_t)(b * 2 + kvh) * HS, VB + (size_t)(b * 2 + kvh) * HS,
                                    (abf*)((unsigned char*)CAT + ((size_t)b * SEQ + qb * 256) * DMODEL + 512 + qh * 64), DMODEL, shm, primed, Qn1, Kn1, qc);
            primed = (Kn1 != nullptr);
            if (pend) { combine(OAPW + (size_t)pbuf * 65536, pb, ph, pqb); pend = 0; }
        }
    }
    if (pend) { asm volatile("s_waitcnt vmcnt(0)" ::: "memory"); __syncthreads(); combine(OAPW + (size_t)pbuf * 65536, pb, ph, pqb); pend = 0; }
    if (!conv_done) { __syncthreads(); { int t_ = threadIdx.x; asm volatile("" : "+v"(t_)); F.tid = t_; F.lane = t_ & 63; } p0_convert_range(F, P0_IN + P0_OUT, P0_NITEMS, F.vcu * NWAVES + F.wave, F.G * NWAVES, (LAS float*)(F.lds + F.wave * 16384), F.lane); __syncthreads(); }
}

__device__ __forceinline__ void p4_fill(Frame& F) {
    int t_ = threadIdx.x; asm volatile("" : "+v"(t_));
    const f32x4* src = (const f32x4*)(F.ws + WS_WR); LAS f32x4* d = (LAS f32x4*)F.lds; for (int i = t_; i < 8192; i += NTHR) d[i] = src[i];
}
__device__ __forceinline__ void p4_route(Frame& F, const bool filled) {
    LAS int* tk_e = (LAS int*)(F.lds + MISC_OFF);
    LAS float* tk_g = (LAS float*)(F.lds + MISC_OFF + 2048);
    LAS int* tk_r = (LAS int*)(F.lds + MISC_OFF + 4096);
    LAS int* lcnt = (LAS int*)(F.lds + MISC_OFF + 6144);
    LAS int* lbase = (LAS int*)(F.lds + MISC_OFF + 6656);
    LAS float* tk_s = (LAS float*)(F.lds + MISC_OFF + 7168);
    const int tid = F.tid, lane = F.lane, wave = F.wave;
    if (!filled) p4_fill(F);
    if (tid < NBIN) lcnt[tid] = 0;
    __syncthreads();
    const bf16_t* x1b = (const bf16_t*)(F.ws + WS_X1B); const float* rb = F.in[I_RB]; int* tokpos = (int*)(F.ws + WS_TP);
    float* rstd_tok = (float*)(F.ws + WS_RSTD); unsigned* gcnt = (unsigned*)(F.ws + WS_CTL);
    int* ent_tok = (int*)(F.ws + WS_ENT); float* ent_gate = (float*)(F.ws + WS_ENT + (size_t)NBIN * CAP * 4);
    using attn_body::f32x16;
    const int e = lane & 31, hi = lane >> 5;
    const float myb = rb[e];
    for (int ch = F.vcu; ch < MTOK / 128; ch += F.G) {
        const int t0 = ch * 128 + wave * 16;
        const bf16_t* xrow = x1b + (size_t)(t0 + (lane & 15)) * DMODEL + 8 * hi;
        const LAS unsigned char* wb = F.lds + e * 2048;
        f32x16 ah = f32x16{}, al = f32x16{}; f32x2 ss2 = (f32x2){0.f, 0.f};
        auto ldx = [&](u32x4 (&v)[8], int k0) {
#pragma unroll
            for (int j = 0; j < 8; ++j) v[j] = *(const u32x4*)(xrow + 16 * (k0 + j)); };
        auto mma8 = [&](const u32x4 (&v)[8], int k0) {
#pragma unroll
            for (int j = 0; j < 8; ++j) {
                const int c = 2 * (k0 + j) + hi;
                const bf16x8 bh = *(const LAS bf16x8*)(wb + ((c ^ (e & 15)) << 4)), bl = *(const LAS bf16x8*)(wb + 65536 + ((c ^ (e & 15)) << 4));
                const bf16x8 a = __builtin_bit_cast(bf16x8, v[j]);
                ah = __builtin_amdgcn_mfma_f32_32x32x16_bf16(a, bh, ah, 0, 0, 0);
                al = __builtin_amdgcn_mfma_f32_32x32x16_bf16(a, bl, al, 0, 0, 0);
                const unsigned aw[4] = {v[j].x, v[j].y, v[j].z, v[j].w};
#pragma unroll
                for (int q = 0; q < 4; ++q) { const f32x2 w = (f32x2){bf_lo(aw[q]), bf_hi(aw[q])}; ss2 += w * w; }
            } };
        u32x4 av[8], bv8[8];
        ldx(av, 0);
#pragma unroll 1
        for (int k0 = 0; k0 < 64; k0 += 16) {
            ldx(bv8, k0 + 8);
            mma8(av, k0);
            if (k0 + 16 < 64) ldx(av, k0 + 16);
            mma8(bv8, k0 + 8);
        }
        float ssum = ss2.x + ss2.y; ssum = sum32f(ssum);
        const float rstd_l = 1.0f / sqrtf(ssum * (1.0f / DMODEL) + EPS);
        if (lane < 16) { tk_s[wave * 16 + lane] = rstd_l; rstd_tok[t0 + lane] = rstd_l; }
        asm volatile("s_waitcnt lgkmcnt(0)" ::: "memory");
        float val[8];
#pragma unroll
        for (int q = 0; q < 8; ++q) val[q] = (ah[q] + al[q]) * tk_s[wave * 16 + attn_body::crow(q, hi)] + myb;
        int se[8][4]; float sv[8][4]; unsigned key[8];
#pragma unroll
        for (int q = 0; q < 8; ++q) { unsigned u = __float_as_uint(val[q]); u = (u & 0x80000000u) ? ~u : (u | 0x80000000u); key[q] = (u & ~31u) | (unsigned)(31 - e); }
#pragma unroll
        for (int k = 0; k < 4; ++k)
#pragma unroll
            for (int q = 0; q < 8; ++q) {
                unsigned m = key[q], o;
                o = (unsigned)dppi<0xB1>((int)m); m = m > o ? m : o; o = (unsigned)xor2i((int)m); m = m > o ? m : o; o = (unsigned)xor4i((int)m); m = m > o ? m : o;
                o = (unsigned)xor8i((int)m); m = m > o ? m : o; o = (unsigned)xor16i((int)m, lane); m = m > o ? m : o;
                se[q][k] = 31 - (int)(m & 31u);
                unsigned u = m & ~31u; u = (u & 0x80000000u) ? (u & 0x7fffffffu) : ~u;
                sv[q][k] = __uint_as_float(u);
                if (key[q] == m) key[q] = 0u;
            }
        if (e == 0) {
#pragma unroll
            for (int q = 0; q < 8; ++q) {
                const int lt = wave * 16 + attn_body::crow(q, hi);
                const float e1 = __expf(sv[q][1] - sv[q][0]), e2 = __expf(sv[q][2] - sv[q][0]), e3 = __expf(sv[q][3] - sv[q][0]); const float inv = 1.0f / (1.0f + e1 + e2 + e3);
                tk_e[lt * 4 + 0] = se[q][0]; tk_e[lt * 4 + 1] = se[q][1]; tk_e[lt * 4 + 2] = se[q][2]; tk_e[lt * 4 + 3] = se[q][3];
                tk_g[lt * 4 + 0] = inv; tk_g[lt * 4 + 1] = e1 * inv; tk_g[lt * 4 + 2] = e2 * inv; tk_g[lt * 4 + 3] = e3 * inv;
            }
        }
        __syncthreads();
        const int mybin = tk_e[tid] * 4 + (tid & 3);
        tk_r[tid] = __hip_atomic_fetch_add(&lcnt[mybin], 1, __ATOMIC_RELAXED, __HIP_MEMORY_SCOPE_WORKGROUP);
        __syncthreads();
        if (tid < NBIN) { const int c = lcnt[tid]; lbase[tid] = c ? (int)atomicAdd(&gcnt[tid], (unsigned)c) : 0; lcnt[tid] = 0; }
        __syncthreads();
        { const int pos = lbase[mybin] + tk_r[tid]; const size_t idx = (size_t)mybin * CAP + pos; ent_tok[idx] = ch * 128 + (tid >> 2); ent_gate[idx] = tk_g[tid]; ent_gate[(size_t)NBIN * CAP + idx] = tk_s[tid >> 2]; tokpos[ch * 512 + tid] = (mybin << 16) | pos; }
        __syncthreads();
    }
}

__device__ __forceinline__ void p7_combine(Frame& F) {
    const int gw = F.vcu * NWAVES + F.wave, NGW = F.G * NWAVES, lane = F.lane;
    const int* tokpos = (const int*)(F.ws + WS_TP); const unsigned char* Y = F.ws + WS_Y; const bf16_t* x1b = (const bf16_t*)(F.ws + WS_X1B);
    for (int t0 = gw; t0 < MTOK; t0 += 2 * NGW) {
        const int t1r = t0 + NGW; const bool h1 = t1r < MTOK; const int t1 = h1 ? t1r : t0;
        const int4 tpa = *(const int4*)(tokpos + 4 * t0), tpb = *(const int4*)(tokpos + 4 * t1);
        const int tpv[2][4] = {{tpa.x, tpa.y, tpa.z, tpa.w}, {tpb.x, tpb.y, tpb.z, tpb.w}};
        const int tt[2] = {t0, t1};
        size_t row[2][4];
#pragma unroll
        for (int u = 0; u < 2; ++u)
#pragma unroll
            for (int k = 0; k < 4; ++k) { const int bin = tpv[u][k] >> 16, pos = tpv[u][k] & 0xffff, e = bin >> 2; row[u][k] = (size_t)(F.MS[MS_BASE + e] + F.MS[MS_CUM + bin] + pos); }
        u32x2 xb[2][4]; unsigned y[2][4][4];
#pragma unroll
        for (int u = 0; u < 2; ++u) {
#pragma unroll
            for (int j = 0; j < 4; ++j) xb[u][j] = __builtin_nontemporal_load((const u32x2*)(x1b + (size_t)tt[u] * DMODEL) + lane + 64 * j);
#pragma unroll
            for (int k = 0; k < 4; ++k)
#pragma unroll
                for (int j = 0; j < 4; ++j) y[u][k][j] = __builtin_nontemporal_load((const unsigned*)(Y + row[u][k] * DMODEL) + lane + 64 * j);
        }
#pragma unroll
        for (int u = 0; u < 2; ++u) {
            if (u == 1 && !h1) break;
            f32x4* op = (f32x4*)(F.out + (size_t)tt[u] * DMODEL) + lane;
#pragma unroll
            for (int j = 0; j < 4; ++j) {
                f32x4 v = (f32x4){bf_lo(xb[u][j].x), bf_hi(xb[u][j].x), bf_lo(xb[u][j].y), bf_hi(xb[u][j].y)};
#pragma unroll
                for (int k = 0; k < 4; ++k) { const f32x2 lo = __builtin_amdgcn_cvt_pk_f32_fp8((int)y[u][k][j], false), hi = __builtin_amdgcn_cvt_pk_f32_fp8((int)y[u][k][j], true); v += (f32x4){lo.x, lo.y, hi.x, hi.y}; }
                __builtin_nontemporal_store(v, op + 64 * j);
            }
        }
    }
}

__device__ __forceinline__ void moe_setup(Frame& F, int mode) {
    const unsigned* gcnt = (const unsigned*)(F.ws + WS_CTL);
    __syncthreads();
    if (F.tid < 64) {
        const int e = F.tid & 31;
        const int c0 = (int)__hip_atomic_load(gcnt + 4 * e, RLX_AGENT), c1 = (int)__hip_atomic_load(gcnt + 4 * e + 1, RLX_AGENT), c2 = (int)__hip_atomic_load(gcnt + 4 * e + 2, RLX_AGENT), c3 = (int)__hip_atomic_load(gcnt + 4 * e + 3, RLX_AGENT);
        const int ne = c0 + c1 + c2 + c3;
        const int nsel = mode < 0 ? ne : (mode == 0 ? c0 : mode == 1 ? c1 : mode == 2 ? c2 : c3);
        const int nt = (nsel + 255) >> 8;
        int sb = ne, st = nt;
#pragma unroll
        for (int o = 1; o < 32; o <<= 1) { const int tb = __shfl_up(sb, o, 32), tt = __shfl_up(st, o, 32); if (e >= o) { sb += tb; st += tt; } }
        if (F.tid < 32) {
            F.MS[MS_CNT + 4 * e] = c0; F.MS[MS_CNT + 4 * e + 1] = c1; F.MS[MS_CNT + 4 * e + 2] = c2; F.MS[MS_CNT + 4 * e + 3] = c3;
            F.MS[MS_CUM + 4 * e] = 0; F.MS[MS_CUM + 4 * e + 1] = c0; F.MS[MS_CUM + 4 * e + 2] = c0 + c1; F.MS[MS_CUM + 4 * e + 3] = c0 + c1 + c2; F.MS[MS_NE + e] = ne;
            F.MS[MS_ADJ + 4 * e] = (4 * e) * CAP; F.MS[MS_ADJ + 4 * e + 1] = (4 * e + 1) * CAP - c0; F.MS[MS_ADJ + 4 * e + 2] = (4 * e + 2) * CAP - (c0 + c1); F.MS[MS_ADJ + 4 * e + 3] = (4 * e + 3) * CAP - (c0 + c1 + c2);
            F.MS[MS_BASE + e] = sb - ne; F.MS[MS_TILE + e] = st - nt;
            if (e == NEXP - 1) { F.MS[MS_BASE + NEXP] = sb; F.MS[MS_TILE + NEXP] = st; }
            for (int rt = st - nt; rt < st; ++rt) F.MS[MS_TEXP + rt] = e;
        }
    }
    __syncthreads();
}

struct Args { const float* in[22]; float* out; unsigned char* ws; int ph_lo, ph_hi, coop, pad; };
constexpr int NPHASE = 8;
#ifndef PHM
#define PHM 0xff
#endif
#define PHON(k) (((PHM) >> (k)) & 1)
#ifndef REP_PH
#define REP_PH -1
#endif
#define REPEAT(k) for (int rep_ = 0; rep_ < ((REP_PH) == (k) ? 2 : 1); ++rep_)

__global__ void __launch_bounds__(NTHR, 2) hymba_fwd(Args args) {
    __builtin_assume(__builtin_amdgcn_workitem_id_y() == 0); __builtin_assume(__builtin_amdgcn_workitem_id_z() == 0);
    extern __shared__ __attribute__((aligned(16))) unsigned char lds[];
    Frame F;
    F.lds = (LAS unsigned char*)lds; F.MS = (LAS int*)(F.lds + MISC_OFF);
    F.tid = threadIdx.x; F.lane = F.tid & 63; F.wave = __builtin_amdgcn_readfirstlane(F.tid >> 6);
    F.G = gridDim.x; { const int bx = blockIdx.x; F.vcu = (F.G % 8 == 0) ? (bx % 8) * (F.G / 8) + bx / 8 : bx; }
    F.ws = args.ws; F.out = args.out;
#pragma unroll
    for (int i = 0; i < 22; ++i) F.in[i] = args.in[i];
    const int lo = args.ph_lo, hi = args.ph_hi;
    XcdBarrier bar; bar.bar = nullptr; bar.x = 0; bar.st = nullptr;
    if (args.coop) {
        if (F.tid < 2) F.MS[MS_BARST + F.tid] = 0;
        __syncthreads();
        bar = xcd_barrier_post((unsigned*)(F.ws + WS_CTL) + CW_BAR, (volatile LAS unsigned*)(F.MS + MS_BARST));
    }
#define FRESH() do { int t_ = threadIdx.x; asm volatile("" : "+v"(t_)); F.tid = t_; F.lane = t_ & 63; } while (0)
#define IN(k) (lo <= (k) && (k) < hi)
#ifndef USE_CG_SYNC0
#define USE_CG_SYNC0 0
#endif
#define SEAM(k) do { if (IN(k) && IN((k) + 1) && args.coop) { if (USE_CG_SYNC0 && (k) == 0) cg::this_grid().sync(); else xcd_barrier(bar); } } while (0)

    REPEAT(0) { if ((REP_PH) == 0 && rep_ == 1) xcd_barrier(bar); FRESH(); if (PHON(0) && IN(0)) p0_prologue(F); }
    SEAM(0);
    REPEAT(1) { if ((REP_PH) == 1 && rep_ == 1) xcd_barrier(bar);
      FRESH(); if (PHON(1) && IN(1)) {
        pg8::DenseOrder S; S.init(F.ws + WS_WIN, MTOK, NPROJ, F.G, (int)blockIdx.x);
        { LAS float* tb = (LAS float*)(F.lds + EPM_OFF);
          if (F.tid < 256) tb[F.tid] = ((const float*)(F.ws + WS_GN))[F.tid]; else if (F.tid < 320) tb[F.tid] = ((const float*)(F.ws + WS_TAB))[F.tid - 256];
          __syncthreads(); }
        EpiInProj E{F.ws, (const LAS float*)(F.lds + EPM_OFF)};
        pg8::gemm_phase<false>(F.lds, (const char*)(F.ws + WS_XN), S, E);
    } }
    SEAM(1);
    REPEAT(2) { if ((REP_PH) == 2 && rep_ == 1) xcd_barrier(bar); FRESH(); if (PHON(2) && IN(2)) p2_attention(F, (char*)lds); }
    SEAM(2);
    REPEAT(3) { if ((REP_PH) == 3 && rep_ == 1) xcd_barrier(bar);
      FRESH(); if (PHON(3) && IN(3)) {
        pg8::DenseOrder S; S.init(F.ws + WS_WOUT, MTOK, DMODEL, F.G, (int)blockIdx.x, 1);
        EpiOutProj E{(const bf16_t*)(F.ws + WS_XN), (const float*)(F.ws + WS_SIG), (bf16_t*)(F.ws + WS_X1B), F.ws + WS_X18};
        pg8::gemm_phase<true>(F.lds, (const char*)(F.ws + WS_CAT), S, E);
        if (PHON(4) && IN(4)) p4_fill(F);
    } }
    SEAM(3);
    FRESH(); if (PHON(4) && IN(4)) p4_route(F, PHON(3) && IN(3));
    SEAM(4);
    REPEAT(5) { if ((REP_PH) == 5 && rep_ == 1) xcd_barrier(bar);
      FRESH(); if (PHON(5) && IN(5)) {
        moe_setup(F, -1);
        MoeUpOrder S{F.MS, F.ws, (const char*)(F.ws + WS_WGU), F.G, F.vcu};
        EpiSwiglu E{F.MS, F.ws, F.in[I_BG], F.in[I_BU], F.ws + WS_MID};
        pg8::gemm_phase<true>(F.lds, (const char*)(F.ws + WS_X18), S, E);
    } }
    SEAM(5);
    REPEAT(6) { if ((REP_PH) == 6 && rep_ == 1) xcd_barrier(bar);
      FRESH(); if (PHON(6) && IN(6)) {
        if (!IN(5)) moe_setup(F, -1);
        MoeDownOrder S{F.MS, (const char*)(F.ws + WS_WD), F.G, F.vcu};
        EpiDownY E{F.MS, F.ws, F.in[I_BD], F.ws + WS_Y};
        pg8::gemm_phase<true>(F.lds, (const char*)(F.ws + WS_MID), S, E);
    } }
    SEAM(6);
    FRESH(); if (PHON(7) && IN(7)) { if (!IN(5) && !IN(6)) moe_setup(F, -1); p7_combine(F); }
#undef IN
#undef SEAM
}

#ifndef N_LAUNCH_MODE
#define N_LAUNCH_MODE 1
#endif
extern "C" void kernel_launch(void* const* d_in, const int* in_sizes, int n_in, void* d_out, int out_size, void* d_ws, size_t ws_size, hipStream_t stream) {
    static int grid = 0;
    if (grid == 0) {
        if (n_in != 22 || out_size != MTOK * DMODEL || ws_size < WS_END) { fprintf(stderr, "kernel_launch: unexpected shapes (n_in %d out %d ws %zu)\n", n_in, out_size, ws_size); grid = -1; return; }
        int dev = 0, cus = 0, per_cu = 0;
        hipGetDevice(&dev); hipDeviceGetAttribute(&cus, hipDeviceAttributeMultiprocessorCount, dev);
        hipFuncSetAttribute((const void*)hymba_fwd, hipFuncAttributeMaxDynamicSharedMemorySize, LDS_BYTES);
        hipOccupancyMaxActiveBlocksPerMultiprocessor(&per_cu, (const void*)hymba_fwd, NTHR, LDS_BYTES);
        if (per_cu < 1) { fprintf(stderr, "kernel_launch: occupancy query says %d blocks/CU\n", per_cu); per_cu = 1; }
        (void)hipGetLastError();
        grid = cus < 256 ? cus : 256;
    }
    if (grid < 0) return;
    (void)hipMemsetAsync((char*)d_ws + WS_CTL, 0, CTL_ZERO_BYTES, stream);
    Args a{};
    for (int i = 0; i < 22; ++i) a.in[i] = (const float*)d_in[i];
    a.out = (float*)d_out; a.ws = (unsigned char*)d_ws;
#if N_LAUNCH_MODE == 1
    a.ph_lo = 0; a.ph_hi = NPHASE; a.coop = 1;
    void* kargs[] = {&a};
    hipError_t e = hipLaunchCooperativeKernel((const void*)hymba_fwd, dim3(grid), dim3(NTHR), kargs, LDS_BYTES, stream);
    if (e != hipSuccess) fprintf(stderr, "cooperative launch failed: %s (grid %d)\n", hipGetErrorString(e), grid);
#else
    for (int p = 0; p < NPHASE; ++p) {
        a.ph_lo = p; a.ph_hi = p + 1; a.coop = 0;
        hipLaunchKernelGGL(hymba_fwd, dim3(grid), dim3(NTHR), LDS_BYTES, stream, a);
    }
#endif
}
```
